# Optimizing an MI355X kernel written in HIP

```python
import jax, jax.numpy as jnp
from jax import lax
import numpy as np

D_MODEL = 1024
BATCH = 8
SEQ = 2048
DEPTH = 2

GRID_W = 64
CTX_LEN = 256
N_MIXERS = 4
GROUP_W = D_MODEL // N_MIXERS
HEAD_DIM = 64
Q_BLOCK = 128
ROPE_THETA = 10000.0
NORM_EPS = 1e-6
A_HEADS = GROUP_W // HEAD_DIM
A_KV_HEADS = 2
LRU_W = GROUP_W
LRU_BLOCKS = 4
CONV_W = 4
CONV_LEFT = (CONV_W - 1) // 2
LRU_C = 8.0
C_HEADS = GROUP_W // HEAD_DIM
C_KV_HEADS = 2
WINDOW = 128
D_HEADS = 4
QK_NOPE = 64
QK_ROPE = 32
V_DIM = GROUP_W // D_HEADS
Q_LORA = 192
KV_LORA = 128
MLA_SCALE = (QK_NOPE + QK_ROPE) ** -0.5
N_EXPERTS = 64
TOP_K = 8
N_EXPERT_GROUPS = 8
TOPK_GROUPS = 4
D_EXPERT = 256
ROUTED_SCALE = 2.5
MOE_BLOCK = 128

IN_SPLITS = (A_HEADS * HEAD_DIM, A_KV_HEADS * HEAD_DIM, A_KV_HEADS * HEAD_DIM,
             LRU_W, LRU_W,
             C_HEADS * HEAD_DIM, C_KV_HEADS * HEAD_DIM, C_KV_HEADS * HEAD_DIM,
             Q_LORA, KV_LORA, QK_ROPE)
IN_COLS = sum(IN_SPLITS)

kernel_name = 'hybrid_parallel_heads_moe_dit'


def rms_norm(x, g):
    xf = x.astype(jnp.float32)
    y = xf * lax.rsqrt(jnp.mean(xf * xf, axis=-1, keepdims=True) + NORM_EPS)
    return (y * g.astype(jnp.float32)).astype(x.dtype)


def modulate(x, shift, scale):
    return x * (1 + scale) + shift


def heads(t, n):
    return t.reshape(t.shape[:-1] + (n, t.shape[-1] // n))


def merge_heads(t):
    return t.reshape(t.shape[:-2] + (t.shape[-2] * t.shape[-1],))


def split_columns(proj):
    return jnp.split(proj, np.cumsum(IN_SPLITS)[:-1].tolist(), axis=-1)


def rope_tables(row, col, rot_dim):
    n = rot_dim // 4
    inv = ROPE_THETA ** (-jnp.arange(n, dtype=jnp.float32) / n)
    ang = jnp.concatenate([row[:, None] * inv, col[:, None] * inv], axis=-1)
    return jnp.cos(ang), jnp.sin(ang)


def apply_rope(x, cos, sin):
    half = x.shape[-1] // 2
    xf = x.astype(jnp.float32)
    x1, x2 = xf[..., :half], xf[..., half:]
    c, s = cos[None, :, None, :], sin[None, :, None, :]
    return jnp.concatenate([x1 * c - x2 * s, x1 * s + x2 * c], axis=-1).astype(x.dtype)


def blocked_attention(q, k, v, scale, sink=None):
    B, S, Hq, d = q.shape
    Hkv = k.shape[2]
    rep = Hq // Hkv
    nb = S // Q_BLOCK
    qb = jnp.moveaxis(q.reshape(B, nb, Q_BLOCK, Hkv, rep, d), 1, 0)

    def one_block(qblk):
        s = jnp.einsum('bqgrd,bkgd->bgrqk', qblk, k).astype(jnp.float32) * scale
        if sink is None:
            p = jax.nn.softmax(s, axis=-1)
        else:
            s_sink = jnp.broadcast_to(sink.astype(jnp.float32).reshape(Hkv, rep)[None, :, :, None, None],
                                      s.shape[:-1] + (1,))
            p = jax.nn.softmax(jnp.concatenate([s_sink, s], axis=-1), axis=-1)[..., 1:]
        return jnp.einsum('bgrqk,bkgd->bqgrd', p.astype(v.dtype), v)

    o = lax.map(one_block, qb)
    return jnp.moveaxis(o, 0, 1).reshape(B, S, Hq, v.shape[-1])


def window_attention(q, k, v, kc, vc, sink, scale):
    B, S, Hq, d = q.shape
    Hkv = k.shape[2]
    rep = Hq // Hkv
    nb = S // Q_BLOCK
    C = kc.shape[1]
    qb = q.reshape(B, nb, Q_BLOCK, Hkv, rep, d)

    def band(t):
        tb = t.reshape(B, nb, Q_BLOCK, Hkv, t.shape[-1])
        tp = jnp.pad(tb, ((0, 0), (1, 1), (0, 0), (0, 0), (0, 0)))
        return jnp.concatenate([tp[:, :-2], tp[:, 1:-1], tp[:, 2:]], axis=2)

    kw, vw = band(k), band(v)
    qi = jnp.arange(Q_BLOCK)
    ki = jnp.arange(3 * Q_BLOCK) - Q_BLOCK
    rel = ki[None, :] - qi[:, None]
    kabs = jnp.arange(nb)[:, None] * Q_BLOCK + ki[None, :]
    allowed = (jnp.abs(rel) <= WINDOW)[None] & ((kabs >= 0) & (kabs < S))[:, None, :]
    s_win = jnp.einsum('bnqgrd,bnkgd->bngrqk', qb, kw).astype(jnp.float32) * scale
    s_win = jnp.where(allowed[None, :, None, None], s_win, -jnp.inf)
    s_ctx = jnp.einsum('bnqgrd,bcgd->bngrqc', qb, kc).astype(jnp.float32) * scale
    s_sink = jnp.broadcast_to(sink.astype(jnp.float32).reshape(Hkv, rep)[None, None, :, :, None, None],
                              s_ctx.shape[:-1] + (1,))
    p = jax.nn.softmax(jnp.concatenate([s_sink, s_ctx, s_win], axis=-1), axis=-1)
    p_ctx = p[..., 1:1 + C].astype(v.dtype)
    p_win = p[..., 1 + C:].astype(v.dtype)
    o = (jnp.einsum('bngrqc,bcgd->bnqgrd', p_ctx, vc)
         + jnp.einsum('bngrqk,bnkgd->bnqgrd', p_win, vw))
    return o.reshape(B, S, Hq, v.shape[-1])


def depthwise_conv(x, w, b):
    L = x.shape[1]
    xp = jnp.pad(x, ((0, 0), (CONV_LEFT, CONV_W - 1 - CONV_LEFT), (0, 0)))
    out = b
    for k in range(CONV_W):
        out = out + xp[:, k:k + L] * w[k]
    return out


def linear_scan(a, b, h0):
    b = b.at[:, 0].add(a[:, 0] * h0)

    def combine(left, right):
        return left[0] * right[0], right[0] * left[1] + right[1]

    return lax.associative_scan(combine, (a, b), axis=1)[1]


def rglru(x, h0, wa, ba, wi, bi, lam):
    B, L, W = x.shape
    xf = x.astype(jnp.float32)
    xg = xf.reshape(B, L, LRU_BLOCKS, W // LRU_BLOCKS)
    r = jax.nn.sigmoid(jnp.einsum('blhi,hij->blhj', xg, wa.astype(jnp.float32)).reshape(B, L, W)
                       + ba.astype(jnp.float32))
    ig = jax.nn.sigmoid(jnp.einsum('blhi,hij->blhj', xg, wi.astype(jnp.float32)).reshape(B, L, W)
                        + bi.astype(jnp.float32))
    log_a = -LRU_C * r * jax.nn.softplus(-lam.astype(jnp.float32))
    a = jnp.exp(log_a)
    b = jnp.sqrt(-jnp.expm1(2.0 * log_a)) * (ig * xf)
    return linear_scan(a, b, h0)


def rglru_bidirectional(x_lat, x_ctx, p):
    B, _, W = x_lat.shape
    h_lat, h_ctx = 0.0, 0.0
    for d in range(2):
        prm = (p['lru_wa'][d], p['lru_ba'][d], p['lru_wi'][d], p['lru_bi'][d], p['lru_lambda'][d])
        xc = x_ctx if d == 0 else jnp.flip(x_ctx, axis=1)
        xl = x_lat if d == 0 else jnp.flip(x_lat, axis=1)
        hc = rglru(xc, jnp.zeros((B, W), jnp.float32), *prm)
        hl = rglru(xl, hc[:, -1], *prm)
        if d == 1:
            hc, hl = jnp.flip(hc, axis=1), jnp.flip(hl, axis=1)
        h_lat = h_lat + hl
        h_ctx = h_ctx + hc
    return h_lat, h_ctx


def mla_queries(cq, p, rope):
    q = heads(rms_norm(cq, p['d_q_norm']) @ p['d_w_uq'], D_HEADS)
    if rope is None:
        return q
    return jnp.concatenate([q[..., :QK_NOPE], apply_rope(q[..., QK_NOPE:], *rope)], axis=-1)


def mla_keys_values(ckv, kr, p, rope):
    kv = heads(rms_norm(ckv, p['d_kv_norm']) @ p['d_w_ukv'], D_HEADS)
    k_nope, v = kv[..., :QK_NOPE], kv[..., QK_NOPE:]
    kr = kr[:, :, None, :]
    if rope is not None:
        kr = apply_rope(kr, *rope)
    k = jnp.concatenate([k_nope, jnp.broadcast_to(kr, k_nope.shape[:-1] + (QK_ROPE,))], axis=-1)
    return k, v


def token_mixers(u, uc, p, rope_hd, rope_r, need_ctx):
    aq, ak, av, bx, bg, cq, ck, cv, dq, dkv, dkr = split_columns(u @ p['w_in'])
    aqc, akc, avc, bxc, bgc, cqc, ckc, cvc, dqc, dkvc, dkrc = split_columns(uc @ p['w_in'])
    sc_hd = HEAD_DIM ** -0.5

    k_a_ctx = rms_norm(heads(akc, A_KV_HEADS), p['a_k_norm'])
    v_a_ctx = heads(avc, A_KV_HEADS)
    k_a = jnp.concatenate([k_a_ctx, apply_rope(rms_norm(heads(ak, A_KV_HEADS), p['a_k_norm']), *rope_hd)], axis=1)
    v_a = jnp.concatenate([v_a_ctx, heads(av, A_KV_HEADS)], axis=1)
    q_a = apply_rope(rms_norm(heads(aq, A_HEADS), p['a_q_norm']), *rope_hd)
    y_a = merge_heads(blocked_attention(q_a, k_a, v_a, sc_hd))

    x_b = depthwise_conv(bx, p['conv_w'], p['conv_b'])
    x_b_ctx = depthwise_conv(bxc, p['conv_w'], p['conv_b'])
    h_b, h_b_ctx = rglru_bidirectional(x_b, x_b_ctx, p)
    y_b = (h_b * jax.nn.gelu(bg.astype(jnp.float32))).astype(u.dtype)

    k_c_ctx, v_c_ctx = heads(ckc, C_KV_HEADS), heads(cvc, C_KV_HEADS)
    y_c = merge_heads(window_attention(apply_rope(heads(cq, C_HEADS), *rope_hd),
                                       apply_rope(heads(ck, C_KV_HEADS), *rope_hd),
                                       heads(cv, C_KV_HEADS), k_c_ctx, v_c_ctx, p['c_sink'], sc_hd))

    k_d_ctx, v_d_ctx = mla_keys_values(dkvc, dkrc, p, None)
    k_d, v_d = mla_keys_values(dkv, dkr, p, rope_r)
    y_d = merge_heads(blocked_attention(mla_queries(dq, p, rope_r),
                                        jnp.concatenate([k_d_ctx, k_d], axis=1),
                                        jnp.concatenate([v_d_ctx, v_d], axis=1), MLA_SCALE))

    y = jnp.concatenate([y_a, y_b, y_c, y_d], axis=-1) @ p['w_out']
    if not need_ctx:
        return y, None

    y_a_ctx = merge_heads(blocked_attention(rms_norm(heads(aqc, A_HEADS), p['a_q_norm']), k_a_ctx, v_a_ctx, sc_hd))
    y_b_ctx = (h_b_ctx * jax.nn.gelu(bgc.astype(jnp.float32))).astype(uc.dtype)
    y_c_ctx = merge_heads(blocked_attention(heads(cqc, C_HEADS), k_c_ctx, v_c_ctx, sc_hd, sink=p['c_sink']))
    y_d_ctx = merge_heads(blocked_attention(mla_queries(dqc, p, None), k_d_ctx, v_d_ctx, MLA_SCALE))
    y_ctx = jnp.concatenate([y_a_ctx, y_b_ctx, y_c_ctx, y_d_ctx], axis=-1) @ p['w_out']
    return y, y_ctx


def swiglu(x, wg, wu, wd):
    return (jax.nn.silu(x @ wg) * (x @ wu)) @ wd


def moe_ffn(u, p):
    T, D = u.shape
    scores = jax.nn.sigmoid((u @ p['router_w']).astype(jnp.float32))
    sel = scores + p['router_bias'].astype(jnp.float32)
    per_group = N_EXPERTS // N_EXPERT_GROUPS
    group_score = lax.top_k(sel.reshape(T, N_EXPERT_GROUPS, per_group), 2)[0].sum(-1)
    _, top_groups = lax.top_k(group_score, TOPK_GROUPS)
    group_mask = jnp.any(top_groups[:, :, None] == jnp.arange(N_EXPERT_GROUPS)[None, None, :], axis=1)
    expert_mask = jnp.repeat(group_mask, per_group, axis=1)
    _, idx = lax.top_k(jnp.where(expert_mask, sel, -jnp.inf), TOP_K)
    w = jnp.take_along_axis(scores, idx, axis=1)
    w = w / jnp.sum(w, axis=-1, keepdims=True) * ROUTED_SCALE

    A = T * TOP_K
    flat_e = idx.reshape(A)
    order = jnp.argsort(flat_e)
    e_sorted = flat_e[order]
    counts = jnp.bincount(flat_e, length=N_EXPERTS)
    padded = (counts + MOE_BLOCK - 1) // MOE_BLOCK * MOE_BLOCK
    pad_end = jnp.cumsum(padded)
    pad_start = pad_end - padded
    start = jnp.cumsum(counts) - counts
    dest = pad_start[e_sorted] + jnp.arange(A) - start[e_sorted]
    n_blocks = -(-A // MOE_BLOCK) + N_EXPERTS
    n_rows = n_blocks * MOE_BLOCK
    row_tok = jnp.zeros((n_rows,), jnp.int32).at[dest].set((order // TOP_K).astype(jnp.int32))
    row_w = jnp.zeros((n_rows,), jnp.float32).at[dest].set(w.reshape(A)[order])
    block_expert = jnp.minimum(jnp.searchsorted(pad_end, jnp.arange(n_blocks) * MOE_BLOCK, side='right'),
                               N_EXPERTS - 1)

    def expert_block(acc, blk):
        rows = blk * MOE_BLOCK
        tok = lax.dynamic_slice(row_tok, (rows,), (MOE_BLOCK,))
        rw = lax.dynamic_slice(row_w, (rows,), (MOE_BLOCK,))
        e = block_expert[blk]
        y = swiglu(u[tok], p['w_gate'][e], p['w_up'][e], p['w_down'][e])
        return acc.at[tok].add((y * rw[:, None]).astype(acc.dtype)), None

    routed, _ = lax.scan(expert_block, jnp.zeros_like(u), jnp.arange(n_blocks))
    return routed + swiglu(u, p['sh_gate'], p['sh_up'], p['sh_down'])


def layer_forward(x, cx, mod_lat, mod_ctx, p, rope_hd, rope_r, need_ctx):
    B, S, D = x.shape
    sh1, sc1, g1, sh2, sc2, g2 = jnp.split(mod_lat[:, None, :], 6, axis=-1)
    csh1, csc1, cg1, csh2, csc2, cg2 = jnp.split(mod_ctx, 6, axis=-1)
    u = modulate(rms_norm(x, p['g_pre_mix']), sh1, sc1)
    uc = modulate(rms_norm(cx, p['g_pre_mix']), csh1, csc1)
    y, y_ctx = token_mixers(u, uc, p, rope_hd, rope_r, need_ctx)
    x = x + g1 * rms_norm(y, p['g_post_mix'])
    v = modulate(rms_norm(x, p['g_pre_ffn']), sh2, sc2).reshape(B * S, D)
    if need_ctx:
        cx = cx + cg1 * rms_norm(y_ctx, p['g_post_mix'])
        vc = modulate(rms_norm(cx, p['g_pre_ffn']), csh2, csc2).reshape(-1, D)
        f = moe_ffn(jnp.concatenate([v, vc], axis=0), p)
        f_lat = f[:B * S]
        cx = cx + cg2 * rms_norm(f[B * S:].reshape(cx.shape), p['g_post_ffn'])
    else:
        f_lat = moe_ffn(v, p)
    x = x + g2 * rms_norm(f_lat.reshape(B, S, D), p['g_post_ffn'])
    return x, cx


def setup_inputs(seed: int = 0) -> dict:
    key = jax.random.key(seed)
    ks = jax.random.split(key, 40)
    f32 = jnp.float32
    L, D = DEPTH, D_MODEL
    BW = LRU_W // LRU_BLOCKS

    def nrm(i, shape, scale):
        return jax.random.normal(ks[i], shape, f32) * scale

    def gain(i, shape):
        return 1.0 + nrm(i, shape, 0.05)

    s = jax.random.uniform(ks[19], (L, 2, LRU_W), f32, 0.9, 0.999) ** (1.0 / LRU_C)
    return {
        'x': nrm(0, (BATCH, SEQ, D), 1.0),
        'c': nrm(1, (BATCH, D), 1.0),
        'ctx': nrm(2, (BATCH, CTX_LEN, D), 1.0),
        'c_ctx': nrm(3, (D,), 1.0),
        'w_mod': nrm(4, (L, D, 6 * D), 0.5 * D ** -0.5),
        'b_mod': nrm(5, (L, 6 * D), 0.02),
        'g_pre_mix': gain(6, (L, D)),
        'g_post_mix': gain(7, (L, D)),
        'g_pre_ffn': gain(8, (L, D)),
        'g_post_ffn': gain(9, (L, D)),
        'w_in': nrm(10, (L, D, IN_COLS), D ** -0.5),
        'a_q_norm': gain(11, (L, HEAD_DIM)),
        'a_k_norm': gain(12, (L, HEAD_DIM)),
        'conv_w': nrm(13, (L, CONV_W, LRU_W), CONV_W ** -0.5),
        'conv_b': nrm(14, (L, LRU_W), 0.02),
        'lru_wa': nrm(15, (L, 2, LRU_BLOCKS, BW, BW), BW ** -0.5),
        'lru_ba': nrm(16, (L, 2, LRU_W), 0.02),
        'lru_wi': nrm(17, (L, 2, LRU_BLOCKS, BW, BW), BW ** -0.5),
        'lru_bi': nrm(18, (L, 2, LRU_W), 0.02),
        'lru_lambda': jnp.log(s) - jnp.log1p(-s),
        'c_sink': nrm(20, (L, C_HEADS), 0.5),
        'd_q_norm': gain(21, (L, Q_LORA)),
        'd_w_uq': nrm(22, (L, Q_LORA, D_HEADS * (QK_NOPE + QK_ROPE)), Q_LORA ** -0.5),
        'd_kv_norm': gain(23, (L, KV_LORA)),
        'd_w_ukv': nrm(24, (L, KV_LORA, D_HEADS * (QK_NOPE + V_DIM)), KV_LORA ** -0.5),
        'w_out': nrm(25, (L, D, D), D ** -0.5),
        'router_w': nrm(26, (L, D, N_EXPERTS), D ** -0.5),
        'router_bias': nrm(27, (L, N_EXPERTS), 0.01),
        'w_gate': nrm(28, (L, N_EXPERTS, D, D_EXPERT), D ** -0.5),
        'w_up': nrm(29, (L, N_EXPERTS, D, D_EXPERT), D ** -0.5),
        'w_down': nrm(30, (L, N_EXPERTS, D_EXPERT, D), D_EXPERT ** -0.5),
        'sh_gate': nrm(31, (L, D, D_EXPERT), D ** -0.5),
        'sh_up': nrm(32, (L, D, D_EXPERT), D ** -0.5),
        'sh_down': nrm(33, (L, D_EXPERT, D), D_EXPERT ** -0.5),
    }


def reference(x, c, ctx, c_ctx, w_mod, b_mod, g_pre_mix, g_post_mix, g_pre_ffn, g_post_ffn,
              w_in, a_q_norm, a_k_norm, conv_w, conv_b, lru_wa, lru_ba, lru_wi, lru_bi, lru_lambda,
              c_sink, d_q_norm, d_w_uq, d_kv_norm, d_w_ukv, w_out,
              router_w, router_bias, w_gate, w_up, w_down, sh_gate, sh_up, sh_down):
    S = x.shape[1]
    ROWS = S // GRID_W
    row = jnp.repeat(jnp.arange(ROWS, dtype=jnp.float32), GRID_W)
    col = jnp.tile(jnp.arange(GRID_W, dtype=jnp.float32), ROWS)
    rope_hd = rope_tables(row, col, HEAD_DIM)
    rope_r = rope_tables(row, col, QK_ROPE)
    c_act = jax.nn.silu(c)
    cctx_act = jax.nn.silu(c_ctx)
    cx = ctx
    for l in range(DEPTH):
        p = {
            'g_pre_mix': g_pre_mix[l], 'g_post_mix': g_post_mix[l],
            'g_pre_ffn': g_pre_ffn[l], 'g_post_ffn': g_post_ffn[l],
            'w_in': w_in[l], 'a_q_norm': a_q_norm[l], 'a_k_norm': a_k_norm[l],
            'conv_w': conv_w[l], 'conv_b': conv_b[l],
            'lru_wa': lru_wa[l], 'lru_ba': lru_ba[l], 'lru_wi': lru_wi[l], 'lru_bi': lru_bi[l],
            'lru_lambda': lru_lambda[l], 'c_sink': c_sink[l],
            'd_q_norm': d_q_norm[l], 'd_w_uq': d_w_uq[l], 'd_kv_norm': d_kv_norm[l], 'd_w_ukv': d_w_ukv[l],
            'w_out': w_out[l], 'router_w': router_w[l], 'router_bias': router_bias[l],
            'w_gate': w_gate[l], 'w_up': w_up[l], 'w_down': w_down[l],
            'sh_gate': sh_gate[l], 'sh_up': sh_up[l], 'sh_down': sh_down[l],
        }
        mod_lat = c_act @ w_mod[l] + b_mod[l]
        mod_ctx = cctx_act @ w_mod[l] + b_mod[l]
        x, cx = layer_forward(x, cx, mod_lat, mod_ctx, p, rope_hd, rope_r, l < DEPTH - 1)
    return x
```

```cpp
#include <hip/hip_runtime.h>
#include <hip/hip_cooperative_groups.h>
#include <cstdio>
#include <cmath>
namespace cg = cooperative_groups;

typedef unsigned short bf16_t;
typedef short bf16x8 __attribute__((ext_vector_type(8)));
typedef short s16x4 __attribute__((ext_vector_type(4)));
typedef float f32x2 __attribute__((ext_vector_type(2)));
typedef float f32x4 __attribute__((ext_vector_type(4)));
typedef float f32x16 __attribute__((ext_vector_type(16)));
typedef unsigned u32x2 __attribute__((ext_vector_type(2)));
typedef unsigned u32x4 __attribute__((ext_vector_type(4)));
typedef __bf16 bf16x2_t __attribute__((ext_vector_type(2)));
#define LAS __attribute__((address_space(3)))

constexpr int D = 1024, NB = 8, SEQ = 2048, CL = 256;
constexpr int NL = NB * SEQ, NC = NB * CL, NT = NL + NC;
constexpr int PLD = 1920;
constexpr int cAQ = 0, cAK = 256, cAV = 384, cBX = 512, cBG = 768, cCQ = 1024, cCK = 1280, cCV = 1408, cDQ = 1536, cDKV = 1728, cDKR = 1856;
constexpr int NE = 64;
constexpr float EPS = 1e-6f;
constexpr float LOG2E = 1.4426950408889634f;
constexpr int LDS_BYTES = 133120, LDS_TAB = 131072, LDS_XST = 132096;

enum { I_X = 0, I_C, I_CTX, I_CCTX, I_WMOD, I_BMOD, I_GPREMIX, I_GPOSTMIX, I_GPREFFN, I_GPOSTFFN, I_WIN, I_AQN, I_AKN, I_CONVW, I_CONVB,
       I_LRUWA, I_LRUBA, I_LRUWI, I_LRUBI, I_LRULAM, I_CSINK, I_DQN, I_DWUQ, I_DKVN, I_DWUKV, I_WOUT, I_RW, I_RB, I_WG, I_WU, I_WD, I_SHG, I_SHU, I_SHD, N_IN };

constexpr size_t MiB = 1u << 20;
constexpr size_t OFF_MOD = 1 * MiB;
constexpr size_t OFF_ROPE = 1572864;
constexpr size_t OFF_CX = 3 * MiB;
constexpr size_t OFF_ROUTE = 11 * MiB;
constexpr size_t RT_IDX = OFF_ROUTE, RT_W = RT_IDX + 589824, RT_POSMAP = RT_W + 589824, RT_LTOK = RT_POSMAP + 589824, RT_LW = RT_LTOK + 589824,
                 RT_TCNT = RT_LW + 589824, RT_EOFF = RT_TCNT + 36864, RT_ECNT = RT_EOFF + 512;
constexpr size_t OFF_AGG = 15 * MiB;
constexpr size_t OFF_WT = 17 * MiB;
constexpr size_t WT_WIN = OFF_WT, WT_WOUT = WT_WIN + 4194304, WT_WGU = WT_WOUT + 2097152, WT_WD = WT_WGU + 68157440, WT_WUQ = WT_WD + 34078720,
                 WT_WUKV = WT_WUQ + 147456, WT_RHI = WT_WUKV + 131072, WT_RLO = WT_RHI + 262144, WT_LRU = WT_RLO + 262144;
constexpr size_t OFF_UH = 122 * MiB;
constexpr size_t OFF_BIG = 203 * MiB;
constexpr size_t BG_PROJ = OFF_BIG, BG_QD = BG_PROJ + 70778880, BG_KD = BG_QD + 14155776, BG_VD = BG_KD + 14155776, BG_DQN = BG_VD + 9437184,
                 BG_DKVN = BG_DQN + 7077888, BG_HL = BG_DKVN + 4718592, BG_PL = BG_HL + 18874368, BG_YMIX = BG_PL + 18874368,
                 BG_YOUT = BG_YMIX + 37748736, BG_VHI = BG_YOUT + 37748736, BG_VLO = BG_VHI + 37748736;
constexpr size_t BG_Y = OFF_BIG;
constexpr size_t WS_NEED = OFF_BIG + 339738624;

struct Params {
  const float* in[N_IN];
  float* out;
  unsigned char* ws;
};

__device__ __forceinline__ float bf2f(bf16_t h) { return __uint_as_float(((unsigned)h) << 16); }
__device__ __forceinline__ unsigned pk2(float lo, float hi) { f32x2 v = {lo, hi}; bf16x2_t b = __builtin_convertvector(v, bf16x2_t); return __builtin_bit_cast(unsigned, b); }
__device__ __forceinline__ bf16_t f2bf(float f) { return (bf16_t)(pk2(f, 0.f) & 0xffffu); }
__device__ __forceinline__ float wave_sum(float v) {
#pragma unroll
  for (int o = 1; o < 64; o <<= 1) v += __shfl_xor(v, o);
  return v;
}
__device__ __forceinline__ float sigmoidf_(float x) { return 1.0f / (1.0f + __expf(-x)); }
__device__ __forceinline__ float gelu_tanh(float x) { const float u = 0.7978845608028654f * (x + 0.044715f * x * x * x); return 0.5f * x * (1.0f + tanhf(u)); }
__device__ __forceinline__ int crow(int r, int hi) { return (r & 3) + 8 * (r >> 2) + 4 * hi; }
__device__ __forceinline__ void unpack4(u32x2 w, float& a, float& b, float& c, float& d) {
  a = __uint_as_float(w.x << 16); b = __uint_as_float(w.x & 0xffff0000u); c = __uint_as_float(w.y << 16); d = __uint_as_float(w.y & 0xffff0000u);
}

typedef const __attribute__((address_space(4))) Params* KP;
__device__ __forceinline__ void relaunder(struct Ctx& c);
__device__ __forceinline__ KP get_ka() { KP k = (KP)__builtin_amdgcn_kernarg_segment_ptr(); asm volatile("" : "+s"(k)); return k; }
struct Ctx {
  KP p; int l; int tid, lane, wid; LAS unsigned char* lds; int nblk, blk;
  int ftid, fwid, fnblk, fblk, hb; LAS unsigned char* flds;
};

__device__ __forceinline__ void relaunder(Ctx& c) {
  c.p = get_ka();
  int t = threadIdx.x; asm volatile("" : "+v"(t));
  c.ftid = t; c.lane = t & 63; c.fwid = __builtin_amdgcn_readfirstlane(t >> 6);
  c.hb = c.fwid >> 2; c.tid = t & 255; c.wid = c.fwid & 3;
  int b = blockIdx.x; asm volatile("" : "+s"(b)); c.fblk = b; c.blk = 2 * b + c.hb;
  int n = gridDim.x; asm volatile("" : "+s"(n)); c.fnblk = n; c.nblk = 2 * n;
  c.lds = c.flds + c.hb * 65536;
}
__device__ __forceinline__ int stage_row(int tid, int i) { return i * 32 + (tid >> 3); }
__device__ __forceinline__ int stage_coff(int tid) { return (((tid & 7) ^ ((tid >> 3) & 7)) << 3); }

__device__ __forceinline__ void gemm_core(const Ctx& c, const bf16_t* const (&ap)[4], const bf16_t* const (&bp)[4], int nkseg, int nseg,
                                          long a0, long a1, long a2, long b0, long b1, long b2, f32x4 (&acc)[4][4]) {
  const int lane = c.lane, wid = c.wid, fr = lane & 15, fq = lane >> 4, wr = wid >> 1, wc = wid & 1;
  LAS unsigned char* lds = c.lds;
#pragma unroll
  for (int m = 0; m < 4; ++m)
#pragma unroll
    for (int n = 0; n < 4; ++n) acc[m][n] = (f32x4){0.f, 0.f, 0.f, 0.f};
  const int nk = nkseg * nseg;
#define GEMM_ISSUE(KT) do { const int kt_ = (KT); const int seg_ = kt_ / nkseg, kk_ = kt_ - seg_ * nkseg; \
    const long ao_ = (seg_ == 0 ? a0 : (seg_ == 1 ? a1 : a2)) + (long)kk_ * 64; \
    const long bo_ = (seg_ == 0 ? b0 : (seg_ == 1 ? b1 : b2)) + (long)kk_ * 64; \
    LAS unsigned char* dst_ = lds + (kt_ & 1) * 32768 + wid * 1024; \
    _Pragma("unroll") for (int i_ = 0; i_ < 4; ++i_) __builtin_amdgcn_global_load_lds((const unsigned*)(ap[i_] + ao_), (LAS unsigned*)(dst_ + i_ * 4096), 16, 0, 0); \
    _Pragma("unroll") for (int i_ = 0; i_ < 4; ++i_) __builtin_amdgcn_global_load_lds((const unsigned*)(bp[i_] + bo_), (LAS unsigned*)(dst_ + 16384 + i_ * 4096), 16, 0, 0); } while (0)
  GEMM_ISSUE(0);
  const int aoff = (wr * 64 + fr) * 128, boff = 16384 + (wc * 64 + fr) * 128, sw = fr & 7;
  for (int kt = 0; kt < nk; ++kt) {
    asm volatile("s_waitcnt vmcnt(0)" ::: "memory");
    __syncthreads();
    if (kt + 1 < nk) GEMM_ISSUE(kt + 1);
    LAS unsigned char* base = lds + (kt & 1) * 32768;
    bf16x8 af[4][2], bfr[4][2];
#pragma unroll
    for (int m = 0; m < 4; ++m)
#pragma unroll
      for (int k = 0; k < 2; ++k) af[m][k] = *(LAS bf16x8*)(base + aoff + m * 2048 + (((k * 4 + fq) ^ sw) << 4));
#pragma unroll
    for (int n = 0; n < 4; ++n)
#pragma unroll
      for (int k = 0; k < 2; ++k) bfr[n][k] = *(LAS bf16x8*)(base + boff + n * 2048 + (((k * 4 + fq) ^ sw) << 4));
#pragma unroll
    for (int k = 0; k < 2; ++k)
#pragma unroll
      for (int m = 0; m < 4; ++m)
#pragma unroll
        for (int n = 0; n < 4; ++n) acc[m][n] = __builtin_amdgcn_mfma_f32_16x16x32_bf16(bfr[n][k], af[m][k], acc[m][n], 0, 0, 0);
  }
  __syncthreads();
}

struct ItemInfo { int a, b, c, d; };
template <class F>
__device__ __forceinline__ void gemm_persistent(const Ctx& c, int nitems, int nk, F& f) {
  const int lane = c.lane, wid = c.wid, fr = lane & 15, fq = lane >> 4, wr = wid >> 1, wc = wid & 1;
  LAS unsigned char* lds = c.lds;
  int cur = c.blk;
  if (cur >= nitems) return;
  const bf16_t *ap[4], *bp[4];
  f.pre(cur);
  ItemInfo ci = f.setup(cur, ap, bp);
  unsigned gs = 0;
#define PG_ISSUE(KT, BUFI) do { const long ko_ = (long)(KT) * 64; LAS unsigned char* dst_ = lds + (BUFI) * 32768 + wid * 1024; \
    _Pragma("unroll") for (int i_ = 0; i_ < 4; ++i_) __builtin_amdgcn_global_load_lds((const unsigned*)(ap[i_] + ko_), (LAS unsigned*)(dst_ + i_ * 4096), 16, 0, 0); \
    _Pragma("unroll") for (int i_ = 0; i_ < 4; ++i_) __builtin_amdgcn_global_load_lds((const unsigned*)(bp[i_] + ko_), (LAS unsigned*)(dst_ + 16384 + i_ * 4096), 16, 0, 0); } while (0)
  PG_ISSUE(0, 0);
  const int aoff = (wr * 64 + fr) * 128, boff = 16384 + (wc * 64 + fr) * 128, sw = fr & 7;
  for (;;) {
    f32x4 acc[4][4];
#pragma unroll
    for (int m = 0; m < 4; ++m)
#pragma unroll
      for (int n = 0; n < 4; ++n) acc[m][n] = (f32x4){0.f, 0.f, 0.f, 0.f};
    const int nxt = cur + c.nblk; const bool has_next = nxt < nitems;
    ItemInfo ni = ci;
    for (int kt = 0; kt < nk; ++kt) {
      asm volatile("s_waitcnt vmcnt(0)" ::: "memory");
      __syncthreads();
      if (kt + 1 < nk) { PG_ISSUE(kt + 1, (gs + 1) & 1); if (kt == nk - 2 && has_next) f.pre(nxt); }
      else if (has_next) { ni = f.setup(nxt, ap, bp); PG_ISSUE(0, (gs + 1) & 1); }
      LAS unsigned char* base = lds + (gs & 1) * 32768;
      bf16x8 af[4][2], bfr[4][2];
#pragma unroll
      for (int m = 0; m < 4; ++m)
#pragma unroll
        for (int k = 0; k < 2; ++k) af[m][k] = *(LAS bf16x8*)(base + aoff + m * 2048 + (((k * 4 + fq) ^ sw) << 4));
#pragma unroll
      for (int n = 0; n < 4; ++n)
#pragma unroll
        for (int k = 0; k < 2; ++k) bfr[n][k] = *(LAS bf16x8*)(base + boff + n * 2048 + (((k * 4 + fq) ^ sw) << 4));
#pragma unroll
      for (int k = 0; k < 2; ++k)
#pragma unroll
        for (int m = 0; m < 4; ++m)
#pragma unroll
          for (int n = 0; n < 4; ++n) acc[m][n] = __builtin_amdgcn_mfma_f32_16x16x32_bf16(bfr[n][k], af[m][k], acc[m][n], 0, 0, 0);
      ++gs;
    }
    f.epi(ci, acc);
    if (!has_next) break;
    cur = nxt; ci = ni;
  }
  __syncthreads();
#undef PG_ISSUE
}

__device__ __forceinline__ int stage_row8(int ftid, int i) { return i * 64 + (ftid >> 3); }
template <int NW, class F>
__device__ __forceinline__ void gemm8_persistent(const Ctx& c, int first, int stride, int nitems, int nk, F& f) {
  const int lane = c.lane, wid = c.fwid, fr = lane & 15, fq = lane >> 4, wr = wid >> 1, wc = wid & 1;
  LAS unsigned char* lds = c.flds;
  int cur = first;
  if (cur >= nitems) return;
  unsigned ap[4], bp[4];
  f.pre(cur);
  ItemInfo ci = f.setup(cur, ap, bp);
  unsigned gs = 0;
  bool skipw = false;
#define PG8_ISSUE(KT, BUFI) do { const long ko_ = (long)(KT) * 64; LAS unsigned char* dst_ = lds + (BUFI) * 65536 + wid * 1024; \
    _Pragma("unroll") for (int i_ = 0; i_ < 4; ++i_) __builtin_amdgcn_global_load_lds((const unsigned*)(f.Abase() + ap[i_] + ko_), (LAS unsigned*)(dst_ + i_ * 8192), 16, 0, 0); \
    _Pragma("unroll") for (int i_ = 0; i_ < NW / 2; ++i_) __builtin_amdgcn_global_load_lds((const unsigned*)(f.Bbase() + bp[i_] + ko_), (LAS unsigned*)(dst_ + 32768 + i_ * 8192), 16, 0, 0); } while (0)
  PG8_ISSUE(0, 0);
  const int aoff = (wr * 64 + fr) * 128, boff = 32768 + (wc * (NW * 16) + fr) * 128, sw = fr & 7;
  for (;;) {
    f32x4 acc[4][NW];
#pragma unroll
    for (int m = 0; m < 4; ++m)
#pragma unroll
      for (int n = 0; n < NW; ++n) acc[m][n] = (f32x4){0.f, 0.f, 0.f, 0.f};
    const int nxt = cur + stride; const bool has_next = nxt < nitems;
    ItemInfo ni = ci;
#pragma unroll 1
    for (int kt = 0; kt < nk; ++kt) {
      if (!skipw) asm volatile("s_waitcnt vmcnt(0)" ::: "memory");
      skipw = false;
      asm volatile("s_waitcnt lgkmcnt(0)\n\ts_barrier" ::: "memory");
      if (kt + 1 >= nk && has_next) ni = f.setup(nxt, ap, bp);
      LAS unsigned char* base = lds + (gs & 1) * 65536;
#pragma unroll
      for (int k = 0; k < 2; ++k) {
        bf16x8 af[4], bfr[NW];
#pragma unroll
        for (int m = 0; m < 4; ++m) af[m] = *(LAS bf16x8*)(base + aoff + m * 2048 + (((k * 4 + fq) ^ sw) << 4));
#pragma unroll
        for (int n = 0; n < NW; ++n) bfr[n] = *(LAS bf16x8*)(base + boff + n * 2048 + (((k * 4 + fq) ^ sw) << 4));
        if (k == 0) {
          if (kt + 1 < nk) { PG8_ISSUE(kt + 1, (gs + 1) & 1); if (kt == nk - 2 && has_next) f.pre(nxt); }
          else if (has_next) { PG8_ISSUE(0, (gs + 1) & 1); }
        }
#pragma unroll
        for (int m = 0; m < 4; ++m)
#pragma unroll
          for (int n = 0; n < NW; ++n) acc[m][n] = __builtin_amdgcn_mfma_f32_16x16x32_bf16(bfr[n], af[m], acc[m][n], 0, 0, 0);
        if (k == 0 && NW == 8) {
#pragma unroll
          for (int q = 0; q < 8; ++q) { __builtin_amdgcn_sched_group_barrier(0x008, 3, 0); __builtin_amdgcn_sched_group_barrier(0x010, 1, 0); }
        }
      }
      ++gs;
    }
    if (has_next) { asm volatile("s_waitcnt vmcnt(0)" ::: "memory"); skipw = true; }
    f.epi(ci, acc);
    if (!has_next) break;
    cur = nxt; ci = ni;
  }
  __syncthreads();
#undef PG8_ISSUE
}

__device__ __forceinline__ void rows_plain(const Ctx& c, const bf16_t* base, long ld, int row0, const bf16_t* (&rp)[4]) {
  const int co = stage_coff(c.tid);
#pragma unroll
  for (int i = 0; i < 4; ++i) rp[i] = base + (long)(row0 + stage_row(c.tid, i)) * ld + co;
}

__device__ __forceinline__ void store_tile_bf16(const Ctx& c, const f32x4 (&acc)[4][4], bf16_t* base, long ld, int row0, int col0, int rows_valid) {
  const int lane = c.lane, wid = c.wid, fr = lane & 15, fq = lane >> 4, wr = wid >> 1, wc = wid & 1;
#pragma unroll
  for (int m = 0; m < 4; ++m) {
    const int rl = wr * 64 + m * 16 + fr;
    if (rl < rows_valid) {
      bf16_t* rp = base + (long)(row0 + rl) * ld + col0 + wc * 64 + 4 * fq;
#pragma unroll
      for (int n = 0; n < 4; ++n) { u32x2 w; w.x = pk2(acc[m][n][0], acc[m][n][1]); w.y = pk2(acc[m][n][2], acc[m][n][3]); *(u32x2*)(rp + n * 16) = w; }
    }
  }
}

__device__ __forceinline__ void tconv256(const Ctx& c, const float* src, int ldn, int ncols, int k0, int n0, bf16_t* dst, bf16_t* dst2, int ldk, int mode, int nrows_dst) {
  LAS unsigned char* T = c.lds;
  LAS unsigned char* T2 = c.lds + 34816;
  const int tid = c.tid, c4 = tid & 63, kg = tid >> 6;
  __syncthreads();
  const bool colok = (n0 + 4 * c4) < ncols;
  const float* sp = src + (long)(k0 + kg * 16) * ldn + n0 + 4 * c4;
  f32x4 va[16];
#pragma unroll
  for (int r = 0; r < 16; ++r) va[r] = colok ? *(const f32x4*)(sp + (long)r * ldn) : (f32x4){0.f, 0.f, 0.f, 0.f};
#pragma unroll
  for (int kq = 0; kq < 4; ++kq) {
    f32x4 v[4];
#pragma unroll
    for (int r = 0; r < 4; ++r) v[r] = va[kq * 4 + r];
#pragma unroll
    for (int e = 0; e < 4; ++e) {
      u32x2 w; w.x = pk2(v[0][e], v[1][e]); w.y = pk2(v[2][e], v[3][e]);
      *(LAS u32x2*)(T + (4 * c4 + e) * 136 + (kg * 16 + kq * 4) * 2) = w;
      if (mode == 3 && c4 < 16) {
        float a0, a1, a2, a3; { u32x2 t = w; unpack4(t, a0, a1, a2, a3); }
        u32x2 w2; w2.x = pk2(v[0][e] - a0, v[1][e] - a1); w2.y = pk2(v[2][e] - a2, v[3][e] - a3);
        *(LAS u32x2*)(T2 + (4 * c4 + e) * 136 + (kg * 16 + kq * 4) * 2) = w2;
      }
    }
  }
  __syncthreads();
#pragma unroll
  for (int j = 0; j < 8; ++j) {
    const int id = j * 256 + tid, n = id >> 3, kc = id & 7;
    const int ng = n0 + n;
    int drow = ng;
    if (mode == 1) drow = 64 * (ng >> 5) + (ng & 31);
    else if (mode == 2) drow = 64 * (ng >> 5) + 32 + (ng & 31);
    if (drow < nrows_dst) {
      const u32x2 a = *(LAS u32x2*)(T + n * 136 + kc * 16), b = *(LAS u32x2*)(T + n * 136 + kc * 16 + 8);
      *(u32x4*)(dst + (long)drow * ldk + k0 + kc * 8) = (u32x4){a.x, a.y, b.x, b.y};
      if (mode == 3) {
        u32x4 o2 = {0u, 0u, 0u, 0u};
        if (n < 64) { const u32x2 a2 = *(LAS u32x2*)(T2 + n * 136 + kc * 16), b2 = *(LAS u32x2*)(T2 + n * 136 + kc * 16 + 8); o2 = (u32x4){a2.x, a2.y, b2.x, b2.y}; }
        *(u32x4*)(dst2 + (long)drow * ldk + k0 + kc * 8) = o2;
      }
    }
  }
}

constexpr int CVS_WIN = 128, CVS_UQ = 6, CVS_UKV = 4, CVS_RT = 16, CVS_LRU = 16, CVS_TOTAL = CVS_WIN + CVS_UQ + CVS_UKV + CVS_RT + CVS_LRU;
constexpr int CVO_TOTAL = 64;
constexpr int CVE_EXP = 1024, CVE_SH = 16, CVE_TOTAL = 3 * CVE_EXP + 3 * CVE_SH;
__device__ __forceinline__ void conv_item_S(const Ctx& c, int l, int it) {
  const KP p = c.p; unsigned char* ws = p->ws;
  if (it < CVS_WIN) { const int kt = it >> 3, nt = it & 7; tconv256(c, p->in[I_WIN] + (long)l * 1024 * 1888, 1888, 1888, kt * 64, nt * 256, (bf16_t*)(ws + WT_WIN), nullptr, 1024, 0, 2048); return; }
  it -= CVS_WIN;
  if (it < CVS_UQ) { const int kt = it >> 1, nt = it & 1; tconv256(c, p->in[I_DWUQ] + (long)l * 192 * 384, 384, 384, kt * 64, nt * 256, (bf16_t*)(ws + WT_WUQ), nullptr, 192, 0, 384); return; }
  it -= CVS_UQ;
  if (it < CVS_UKV) { const int kt = it >> 1, nt = it & 1; tconv256(c, p->in[I_DWUKV] + (long)l * 128 * 512, 512, 512, kt * 64, nt * 256, (bf16_t*)(ws + WT_WUKV), nullptr, 128, 0, 512); return; }
  it -= CVS_UKV;
  if (it < CVS_RT) { tconv256(c, p->in[I_RW] + (long)l * 1024 * 64, 64, 64, it * 64, 0, (bf16_t*)(ws + WT_RHI), (bf16_t*)(ws + WT_RLO), 1024, 3, 128); return; }
  it -= CVS_RT;
  { const int gate = it / 8, r = it % 8, d = r / 4, h = r % 4;
    tconv256(c, p->in[gate ? I_LRUWI : I_LRUWA] + ((long)((l * 2 + d) * 4 + h)) * 4096, 64, 64, 0, 0, (bf16_t*)(ws + WT_LRU) + ((long)((d * 2 + gate) * 4 + h)) * 4096, nullptr, 64, 0, 64); }
}
__device__ __forceinline__ void conv_item_O(const Ctx& c, int l, int it) {
  const int kt = it >> 2, nt = it & 3;
  tconv256(c, c.p->in[I_WOUT] + (long)l * 1024 * 1024, 1024, 1024, kt * 64, nt * 256, (bf16_t*)(c.p->ws + WT_WOUT), nullptr, 1024, 0, 1024);
}
__device__ __forceinline__ void conv_item_E(const Ctx& c, int l, int it) {
  const KP p = c.p; unsigned char* ws = p->ws;
  if (it < 2 * CVE_EXP) {
    const int up = it / CVE_EXP, r = it % CVE_EXP, e = r >> 4, kt = r & 15;
    tconv256(c, p->in[up ? I_WU : I_WG] + ((long)(l * 64 + e)) * 1024 * 256, 256, 256, kt * 64, 0, (bf16_t*)(ws + WT_WGU) + (long)e * 512 * 1024, nullptr, 1024, 1 + up, 512); return;
  }
  it -= 2 * CVE_EXP;
  if (it < CVE_EXP) {
    const int e = it >> 4, t = it & 15, kt = t >> 2, nt = t & 3;
    tconv256(c, p->in[I_WD] + ((long)(l * 64 + e)) * 256 * 1024, 1024, 1024, kt * 64, nt * 256, (bf16_t*)(ws + WT_WD) + (long)e * 1024 * 256, nullptr, 256, 0, 1024); return;
  }
  it -= CVE_EXP;
  if (it < 2 * CVE_SH) { const int up = it / CVE_SH, kt = it % CVE_SH;
    tconv256(c, p->in[up ? I_SHU : I_SHG] + (long)l * 1024 * 256, 256, 256, kt * 64, 0, (bf16_t*)(ws + WT_WGU) + (long)64 * 512 * 1024, nullptr, 1024, 1 + up, 512); return; }
  it -= 2 * CVE_SH;
  { const int kt = it >> 2, nt = it & 3;
    tconv256(c, p->in[I_SHD] + (long)l * 256 * 1024, 1024, 1024, kt * 64, nt * 256, (bf16_t*)(ws + WT_WD) + (long)64 * 1024 * 256, nullptr, 256, 0, 1024); }
}
__device__ __forceinline__ void phase_convert_S(const Ctx& c, int l) { for (int it = c.blk; it < CVS_TOTAL; it += c.nblk) conv_item_S(c, l, it); }

__device__ __forceinline__ void mod_item(const Ctx& c, int it) {
  const KP p = c.p;
  const int l = it / 96, cg_ = it % 96, tid = c.ftid;
  LAS float* sact = (LAS float*)c.flds;
  LAS float* red = sact + 9 * 1024;
  __syncthreads();
  for (int i = tid; i < 9 * 1024; i += 512) {
    const int r = i >> 10, k = i & 1023;
    const float v = (r < 8) ? p->in[I_C][r * 1024 + k] : p->in[I_CCTX][k];
    sact[i] = v / (1.0f + __expf(-v));
  }
  __syncthreads();
  const int kg = tid >> 6, n = cg_ * 64 + (tid & 63);
  const float* w = p->in[I_WMOD] + (long)l * 1024 * 6144 + n;
  float a[9];
#pragma unroll
  for (int r = 0; r < 9; ++r) a[r] = 0.f;
#pragma unroll 1
  for (int k0 = kg * 128; k0 < kg * 128 + 128; k0 += 16) {
    float wv[16];
#pragma unroll
    for (int q = 0; q < 16; ++q) wv[q] = w[(long)(k0 + q) * 6144];
#pragma unroll
    for (int q4 = 0; q4 < 4; ++q4)
#pragma unroll
      for (int r = 0; r < 9; ++r) {
        const f32x4 s = *(LAS f32x4*)(sact + r * 1024 + k0 + 4 * q4);
        a[r] += s[0] * wv[4 * q4] + s[1] * wv[4 * q4 + 1] + s[2] * wv[4 * q4 + 2] + s[3] * wv[4 * q4 + 3];
      }
  }
#pragma unroll
  for (int r = 0; r < 9; ++r) red[(kg * 9 + r) * 64 + (tid & 63)] = a[r];
  __syncthreads();
  for (int i = tid; i < 9 * 64; i += 512) {
    const int r = i >> 6, nn = i & 63;
    float s = 0.f;
#pragma unroll
    for (int g = 0; g < 8; ++g) s += red[(g * 9 + r) * 64 + nn];
    ((float*)(p->ws + OFF_MOD))[((long)l * 9 + r) * 6144 + cg_ * 64 + nn] = s + p->in[I_BMOD][l * 6144 + cg_ * 64 + nn];
  }
}

__device__ __forceinline__ void sincos_d(double th, float& s, float& co) {
  const double TWO_PI = 6.283185307179586476925;
  const double k = __builtin_rint(th / TWO_PI);
  const double r = th - k * TWO_PI;
  const double h = r * 0.125, h2 = h * h;
  double sh = h * (1.0 + h2 * (-1.0 / 6.0 + h2 * (1.0 / 120.0 + h2 * (-1.0 / 5040.0 + h2 * (1.0 / 362880.0 + h2 * (-1.0 / 39916800.0))))));
  double ch = 1.0 + h2 * (-0.5 + h2 * (1.0 / 24.0 + h2 * (-1.0 / 720.0 + h2 * (1.0 / 40320.0 + h2 * (-1.0 / 3628800.0 + h2 * (1.0 / 479001600.0))))));
#pragma unroll
  for (int i = 0; i < 3; ++i) { const double s2 = 2.0 * sh * ch, c2 = 1.0 - 2.0 * sh * sh; sh = s2; ch = c2; }
  s = (float)sh; co = (float)ch;
}
__device__ __forceinline__ void phase_rope_tables(const Ctx& c) {
  float* hc = (float*)(c.p->ws + OFF_ROPE); float* hs = hc + 2048 * 32; float* rc = hs + 2048 * 32; float* rs = rc + 2048 * 16;
  const long gt = (long)c.blk * 256 + c.tid, gs = (long)c.nblk * 256;
  for (long i = gt; i < 2048 * 48; i += gs) {
    const int t = (int)(i / 48), j = (int)(i % 48);
    const float row = (float)(t >> 6), col = (float)(t & 63);
    float s, co;
    if (j < 32) { const float ang = ((j < 16) ? row : col) * __builtin_amdgcn_exp2f(-(float)(j & 15) * (13.287712379549449f / 16.0f)); sincos_d((double)ang, s, co); hc[t * 32 + j] = co; hs[t * 32 + j] = s; }
    else { const int jj = j - 32; const float ang = ((jj < 8) ? row : col) * __builtin_amdgcn_exp2f(-(float)(jj & 7) * (13.287712379549449f / 8.0f)); sincos_d((double)ang, s, co); rc[t * 16 + jj] = co; rs[t * 16 + jj] = s; }
  }
}

__device__ __forceinline__ const float* mod_ptr(const Ctx& c, int l, int row) { const int rb = row < NL ? (row >> 11) : 8; return (const float*)(c.p->ws + OFF_MOD) + ((long)l * 9 + rb) * 6144; }
__device__ __forceinline__ float* xs_row(const Ctx& c, int row) { return row < NL ? c.p->out + (long)row * D : (float*)(c.p->ws + OFF_CX) + (long)(row - NL) * D; }
__device__ __forceinline__ const float* xin_row(const Ctx& c, int row) { return row < NL ? c.p->in[I_X] + (long)row * D : c.p->in[I_CTX] + (long)(row - NL) * D; }

__device__ __forceinline__ void norm_mod_store(const Ctx& c, const f32x4 (&x)[4], const float* g, const float* sh, const float* sc, bf16_t* orow, bf16_t* orow_lo) {
  float ss = 0.f;
#pragma unroll
  for (int j = 0; j < 4; ++j) ss += x[j][0] * x[j][0] + x[j][1] * x[j][1] + x[j][2] * x[j][2] + x[j][3] * x[j][3];
  const float rs = rsqrtf(wave_sum(ss) * (1.0f / D) + EPS);
#pragma unroll
  for (int j = 0; j < 4; ++j) {
    const int e = 256 * j + 4 * c.lane;
    const f32x4 gv = *(const f32x4*)(g + e), shv = *(const f32x4*)(sh + e), scv = *(const f32x4*)(sc + e);
    float u[4];
#pragma unroll
    for (int i = 0; i < 4; ++i) u[i] = (x[j][i] * rs * gv[i]) * (1.0f + scv[i]) + shv[i];
    u32x2 w; w.x = pk2(u[0], u[1]); w.y = pk2(u[2], u[3]);
    *(u32x2*)(orow + e) = w;
    if (orow_lo) {
      float a, b, cc, d; unpack4(w, a, b, cc, d);
      u32x2 w2; w2.x = pk2(u[0] - a, u[1] - b); w2.y = pk2(u[2] - cc, u[3] - d);
      *(u32x2*)(orow_lo + e) = w2;
    }
  }
}

__device__ __forceinline__ void phase_u0(const Ctx& c) {
  const int gw = c.blk * 4 + c.wid, ngw = c.nblk * 4;
  for (int row = gw; row < NT; row += ngw) {
    const float* xr = xin_row(c, row);
    f32x4 x[4];
#pragma unroll
    for (int j = 0; j < 4; ++j) x[j] = *(const f32x4*)(xr + 256 * j + 4 * c.lane);
    const float* md = mod_ptr(c, 0, row);
    norm_mod_store(c, x, c.p->in[I_GPREMIX], md, md + 1024, (bf16_t*)(c.p->ws + OFF_UH) + (long)row * D, nullptr);
  }
}

struct PlainGemmF {
  const bf16_t* A; const bf16_t* B; bf16_t* C; int lda, ldb, ldc, ntn, nm, tid, lane, wid;
  __device__ __forceinline__ void pre(int) {}
  __device__ __forceinline__ ItemInfo setup(int it, const bf16_t* (&ap)[4], const bf16_t* (&bp)[4]) {
    const int xcd = it & 7, j = it >> 3, per_g = 8 * ntn, g = j / per_g, jj = j - g * per_g;
    const int nml = nm >> 3, gsz = (nml - 8 * g) < 8 ? (nml - 8 * g) : 8;
    const int nt = jj / gsz, mt = (g * 8 + (jj - nt * gsz)) * 8 + xcd; const int co = stage_coff(tid);
#pragma unroll
    for (int i = 0; i < 4; ++i) { ap[i] = A + (long)(mt * 128 + stage_row(tid, i)) * lda + co; bp[i] = B + (long)(nt * 128 + stage_row(tid, i)) * ldb + co; }
    return ItemInfo{mt, nt, 0, 0};
  }
  __device__ __forceinline__ void epi(const ItemInfo& ii, const f32x4 (&acc)[4][4]) {
    const int fr = lane & 15, fq = lane >> 4, wr = wid >> 1, wc = wid & 1;
#pragma unroll
    for (int m = 0; m < 4; ++m) {
      bf16_t* rp = C + (long)(ii.a * 128 + wr * 64 + m * 16 + fr) * ldc + ii.b * 128 + wc * 64 + 4 * fq;
#pragma unroll
      for (int n = 0; n < 4; ++n) { u32x2 w; w.x = pk2(acc[m][n][0], acc[m][n][1]); w.y = pk2(acc[m][n][2], acc[m][n][3]); *(u32x2*)(rp + n * 16) = w; }
    }
  }
};
template <int NW>
struct Plain8F {
  const bf16_t* A; const bf16_t* B; bf16_t* C; int lda, ldb, ldc, ntn, nm, ncols, it0, ftid, lane, fwid;
  __device__ __forceinline__ void pre(int) {}
  __device__ __forceinline__ bool diag() const { return false; }
  __device__ __forceinline__ const bf16_t* Abase() const { return A; }
  __device__ __forceinline__ const bf16_t* Bbase() const { return B; }
  __device__ __forceinline__ ItemInfo setup(int it, unsigned (&ap)[4], unsigned (&bp)[4]) {
    const int tl = it0 + (NW == 8 ? it : (it >> 2)), sub = (NW == 8) ? 0 : (it & 3);
    const int xcd = tl & 7, j = tl >> 3, per_g = 8 * ntn, g = j / per_g, jj = j - g * per_g;
    const int nml = nm >> 3, gsz = (nml - 8 * g) < 8 ? (nml - 8 * g) : 8;
    const int nt = jj / gsz, mt = (g * 8 + (jj - nt * gsz)) * 8 + xcd; const int co = stage_coff(ftid);
    const int col0 = nt * 256 + sub * 64;
#pragma unroll
    for (int i = 0; i < 4; ++i) { ap[i] = (unsigned)((mt * 256 + stage_row8(ftid, i)) * lda + co); bp[i] = (unsigned)((col0 + stage_row8(ftid, i)) * ldb + co); }
    return ItemInfo{mt, col0, 0, 0};
  }
  __device__ __forceinline__ void epi(const ItemInfo& ii, const f32x4 (&acc)[4][NW]) {
    const int fr = lane & 15, fq = lane >> 4, wr = fwid >> 1, wc = fwid & 1;
#pragma unroll
    for (int m = 0; m < 4; ++m) {
      const int col0 = ii.b + wc * (NW * 16) + 4 * fq;
      bf16_t* rp = C + (long)(ii.a * 256 + wr * 64 + m * 16 + fr) * ldc + col0;
#pragma unroll
      for (int n = 0; n < NW; ++n) if (col0 + n * 16 < ncols) { u32x2 w; w.x = pk2(acc[m][n][0], acc[m][n][1]); w.y = pk2(acc[m][n][2], acc[m][n][3]); *(u32x2*)(rp + n * 16) = w; }
    }
  }
};
__device__ __forceinline__ void plain_gemm8(const Ctx& c, const bf16_t* A, const bf16_t* B, bf16_t* C, int lda, int ldb, int ldc, int nm, int ntn, int ncols, int nk) {
  const int ntile = nm * ntn, nfull = (ntile / c.fnblk) * c.fnblk;
  if (nfull > 0) { Plain8F<8> f{A, B, C, lda, ldb, ldc, ntn, nm, ncols, 0, c.ftid, c.lane, c.fwid}; gemm8_persistent<8>(c, c.fblk, c.fnblk, nfull, nk, f); }
  if (ntile > nfull) { Plain8F<2> f{A, B, C, lda, ldb, ldc, ntn, nm, ncols, nfull, c.ftid, c.lane, c.fwid}; gemm8_persistent<2>(c, c.fblk, c.fnblk, (ntile - nfull) * 4, nk, f); }
}
__device__ __forceinline__ void phase_inproj(const Ctx& c) {
  plain_gemm8(c, (const bf16_t*)(c.p->ws + OFF_UH), (const bf16_t*)(c.p->ws + WT_WIN), (bf16_t*)(c.p->ws + BG_PROJ), D, D, PLD, NT / 256, 8, PLD, 16);
}

__device__ __forceinline__ void head4(float (&v)[4], bool norm, const float* gain, const f32x4 cs, const f32x4 sn, float scale, int lane) {
  if (norm) {
    float ss = v[0] * v[0] + v[1] * v[1] + v[2] * v[2] + v[3] * v[3];
    ss += __shfl_xor(ss, 1); ss += __shfl_xor(ss, 2); ss += __shfl_xor(ss, 4); ss += __shfl_xor(ss, 8);
    const float rs = rsqrtf(ss * (1.0f / 64.0f) + EPS);
    const f32x4 g = *(const f32x4*)(gain + 4 * (lane & 15));
#pragma unroll
    for (int i = 0; i < 4; ++i) v[i] = v[i] * rs * g[i];
  }
  const bool first = (lane & 8) == 0;
#pragma unroll
  for (int i = 0; i < 4; ++i) {
    const float pv = __shfl_xor(v[i], 8);
    v[i] = (first ? (v[i] * cs[i] - pv * sn[i]) : (pv * sn[i] + v[i] * cs[i])) * scale;
  }
}
struct MixRowIn { u32x2 w0, w1, w4, w5, w6, w7; f32x4 cs, sn, c2, s2; };
__device__ __forceinline__ void mixer_row_load(const Ctx& c, int row, MixRowIn& in) {
  const KP p = c.p; const int lane = c.lane;
  const bf16_t* pr = (const bf16_t*)(p->ws + BG_PROJ) + (long)row * PLD;
  in.w0 = *(const u32x2*)(pr + 4 * lane); in.w1 = *(const u32x2*)(pr + 256 + 4 * lane); in.w4 = *(const u32x2*)(pr + 1024 + 4 * lane);
  in.w5 = *(const u32x2*)(pr + 1280 + 4 * lane); in.w6 = *(const u32x2*)(pr + 1536 + 4 * lane); in.w7 = *(const u32x2*)(pr + 1792 + 4 * (lane & 31));
  in.cs = (f32x4){1.f, 1.f, 1.f, 1.f}; in.sn = (f32x4){0.f, 0.f, 0.f, 0.f}; in.c2 = in.cs; in.s2 = in.sn;
  if (row < NL) {
    const int t = row & 2047;
    const float* hc = (const float*)(p->ws + OFF_ROPE) + t * 32; const float* rc = (const float*)(p->ws + OFF_ROPE) + 2 * 2048 * 32 + t * 16;
    in.cs = *(const f32x4*)(hc + 4 * (lane & 7)); in.sn = *(const f32x4*)(hc + 2048 * 32 + 4 * (lane & 7));
    in.c2 = *(const f32x4*)(rc + 4 * (lane & 3)); in.s2 = *(const f32x4*)(rc + 2048 * 16 + 4 * (lane & 3));
  }
}
__device__ __forceinline__ void mixer_row(const Ctx& c, int l, int row, const MixRowIn& in) {
  const KP p = c.p; const int lane = c.lane;
  bf16_t* pr = (bf16_t*)(p->ws + BG_PROJ) + (long)row * PLD;
  const u32x2 w0 = in.w0, w1 = in.w1, w4 = in.w4, w5 = in.w5, w6 = in.w6, w7 = in.w7;
  const f32x4 cs = in.cs, sn = in.sn, c2 = in.c2, s2 = in.s2;
  const float qscale = 0.125f * LOG2E;
  float v[4];
  unpack4(w0, v[0], v[1], v[2], v[3]); head4(v, true, p->in[I_AQN] + l * 64, cs, sn, qscale, lane);
  { u32x2 o; o.x = pk2(v[0], v[1]); o.y = pk2(v[2], v[3]); *(u32x2*)(pr + 4 * lane) = o; }
  unpack4(w1, v[0], v[1], v[2], v[3]); head4(v, true, p->in[I_AKN] + l * 64, cs, sn, 1.0f, lane);
  if (lane < 32) { u32x2 o; o.x = pk2(v[0], v[1]); o.y = pk2(v[2], v[3]); *(u32x2*)(pr + 256 + 4 * lane) = o; }
  unpack4(w4, v[0], v[1], v[2], v[3]); head4(v, false, nullptr, cs, sn, qscale, lane);
  { u32x2 o; o.x = pk2(v[0], v[1]); o.y = pk2(v[2], v[3]); *(u32x2*)(pr + 1024 + 4 * lane) = o; }
  unpack4(w5, v[0], v[1], v[2], v[3]); head4(v, false, nullptr, cs, sn, 1.0f, lane);
  if (lane < 32) { u32x2 o; o.x = pk2(v[0], v[1]); o.y = pk2(v[2], v[3]); *(u32x2*)(pr + 1280 + 4 * lane) = o; }
  float a6[4], a7[4];
  unpack4(w6, a6[0], a6[1], a6[2], a6[3]); unpack4(w7, a7[0], a7[1], a7[2], a7[3]);
  const float s6 = a6[0] * a6[0] + a6[1] * a6[1] + a6[2] * a6[2] + a6[3] * a6[3], s7 = a7[0] * a7[0] + a7[1] * a7[1] + a7[2] * a7[2] + a7[3] * a7[3];
  const float ssq = wave_sum(lane < 48 ? s6 : 0.f);
  const float sskv = wave_sum((lane >= 48 ? s6 : 0.f) + (lane < 16 ? s7 : 0.f));
  const float rq = rsqrtf(ssq * (1.0f / 192.0f) + EPS), rkv = rsqrtf(sskv * (1.0f / 128.0f) + EPS);
  if (lane < 48) {
    const f32x4 g = *(const f32x4*)(p->in[I_DQN] + l * 192 + 4 * lane);
    u32x2 o; o.x = pk2(a6[0] * rq * g[0], a6[1] * rq * g[1]); o.y = pk2(a6[2] * rq * g[2], a6[3] * rq * g[3]);
    *(u32x2*)((bf16_t*)(p->ws + BG_DQN) + (long)row * 192 + 4 * lane) = o;
  } else {
    const f32x4 g = *(const f32x4*)(p->in[I_DKVN] + l * 128 + 4 * (lane - 48));
    u32x2 o; o.x = pk2(a6[0] * rkv * g[0], a6[1] * rkv * g[1]); o.y = pk2(a6[2] * rkv * g[2], a6[3] * rkv * g[3]);
    *(u32x2*)((bf16_t*)(p->ws + BG_DKVN) + (long)row * 128 + 4 * (lane - 48)) = o;
  }
  if (lane < 16) {
    const f32x4 g = *(const f32x4*)(p->in[I_DKVN] + l * 128 + 64 + 4 * lane);
    u32x2 o; o.x = pk2(a7[0] * rkv * g[0], a7[1] * rkv * g[1]); o.y = pk2(a7[2] * rkv * g[2], a7[3] * rkv * g[3]);
    *(u32x2*)((bf16_t*)(p->ws + BG_DKVN) + (long)row * 128 + 64 + 4 * lane) = o;
  }
  {
    const bool first = (lane & 4) == 0;
    float y[4];
#pragma unroll
    for (int i = 0; i < 4; ++i) { const float pv = __shfl_xor(a7[i], 4); y[i] = first ? (a7[i] * c2[i] - pv * s2[i]) : (pv * s2[i] + a7[i] * c2[i]); }
    if (lane >= 16 && lane < 24) {
      u32x2 o; o.x = pk2(y[0], y[1]); o.y = pk2(y[2], y[3]);
      bf16_t* kd = (bf16_t*)(p->ws + BG_KD) + (long)row * 384 + 64 + 4 * (lane - 16);
      *(u32x2*)(kd) = o; *(u32x2*)(kd + 96) = o; *(u32x2*)(kd + 192) = o; *(u32x2*)(kd + 288) = o;
    }
  }
}

__device__ __forceinline__ void lru_scan_item(const Ctx& c, int l, int item) {
  const KP p = c.p;
  const int b = item / 72, rem = item % 72, d = rem / 36, q = rem % 36;
  const int tid = c.tid, lane = c.lane, fr = lane & 15, fq = lane >> 4, h = c.wid;
  const bool isctx = q < 4;
  const int seqlen = isctx ? CL : SEQ;
  const int rowbase = isctx ? NL + b * CL : b * SEQ;
  const int pos0 = (d == 0) ? (isctx ? 64 * q : 64 * q - 256) : (isctx ? 255 - 64 * q : 2303 - 64 * q);
  const int step = (d == 0) ? 1 : -1;
  const bf16_t* PROJ = (const bf16_t*)(p->ws + BG_PROJ);
  LAS bf16_t* XB = (LAS bf16_t*)c.lds;
  __syncthreads();
  {
    const int og = tid & 31, pg = tid >> 5;
    const int pa = pos0 + step * (pg * 8), pb = pos0 + step * (pg * 8 + 7);
    const int pmin = pa < pb ? pa : pb;
    float X[11][8];
    const bf16_t* xbase = PROJ + (long)rowbase * PLD + cBX + og * 8;
#pragma unroll
    for (int k = 0; k < 11; ++k) {
      const int r = pmin - 1 + k;
      u32x4 w = {0u, 0u, 0u, 0u};
      if (r >= 0 && r < seqlen) w = *(const u32x4*)(xbase + (long)r * PLD);
      X[k][0] = __uint_as_float(w.x << 16); X[k][1] = __uint_as_float(w.x & 0xffff0000u); X[k][2] = __uint_as_float(w.y << 16); X[k][3] = __uint_as_float(w.y & 0xffff0000u);
      X[k][4] = __uint_as_float(w.z << 16); X[k][5] = __uint_as_float(w.z & 0xffff0000u); X[k][6] = __uint_as_float(w.w << 16); X[k][7] = __uint_as_float(w.w & 0xffff0000u);
    }
    const float* cw = p->in[I_CONVW] + l * 4 * 256 + og * 8;
    float cwv[4][8], cbv[8];
#pragma unroll
    for (int q = 0; q < 4; ++q) { const f32x4 a = *(const f32x4*)(cw + q * 256), b2 = *(const f32x4*)(cw + q * 256 + 4);
      cwv[q][0] = a[0]; cwv[q][1] = a[1]; cwv[q][2] = a[2]; cwv[q][3] = a[3]; cwv[q][4] = b2[0]; cwv[q][5] = b2[1]; cwv[q][6] = b2[2]; cwv[q][7] = b2[3]; }
    { const f32x4 a = *(const f32x4*)(p->in[I_CONVB] + l * 256 + og * 8), b2 = *(const f32x4*)(p->in[I_CONVB] + l * 256 + og * 8 + 4);
      cbv[0] = a[0]; cbv[1] = a[1]; cbv[2] = a[2]; cbv[3] = a[3]; cbv[4] = b2[0]; cbv[5] = b2[1]; cbv[6] = b2[2]; cbv[7] = b2[3]; }
#pragma unroll
    for (int ii = 0; ii < 8; ++ii) {
      float o[8];
#pragma unroll
      for (int e = 0; e < 8; ++e) {
        const float f0 = cbv[e] + cwv[0][e] * X[ii][e] + cwv[1][e] * X[ii + 1][e] + cwv[2][e] * X[ii + 2][e] + cwv[3][e] * X[ii + 3][e];
        const float f1 = cbv[e] + cwv[0][e] * X[7 - ii][e] + cwv[1][e] * X[8 - ii][e] + cwv[2][e] * X[9 - ii][e] + cwv[3][e] * X[10 - ii][e];
        o[e] = (d == 0) ? f0 : f1;
      }
      u32x4 w; w.x = pk2(o[0], o[1]); w.y = pk2(o[2], o[3]); w.z = pk2(o[4], o[5]); w.w = pk2(o[6], o[7]);
      *(LAS u32x4*)((LAS unsigned char*)XB + (pg * 8 + ii) * 528 + og * 16) = w;
    }
  }
  __syncthreads();
  const bf16_t* wtA = (const bf16_t*)(p->ws + WT_LRU) + ((long)((d * 2 + 0) * 4 + h)) * 4096;
  const bf16_t* wtI = (const bf16_t*)(p->ws + WT_LRU) + ((long)((d * 2 + 1) * 4 + h)) * 4096;
  bf16x8 wa[4][2], wi[4][2];
#pragma unroll
  for (int ni = 0; ni < 4; ++ni)
#pragma unroll
    for (int kk = 0; kk < 2; ++kk) {
      wa[ni][kk] = *(const bf16x8*)(wtA + (ni * 16 + fr) * 64 + kk * 32 + 8 * fq);
      wi[ni][kk] = *(const bf16x8*)(wtI + (ni * 16 + fr) * 64 + kk * 32 + 8 * fq);
    }
  float ba[4], bi[4], sp8[4], H0[4], P0[4];
#pragma unroll
  for (int ni = 0; ni < 4; ++ni) {
    const int ch = 64 * h + 16 * ni + fr;
    ba[ni] = p->in[I_LRUBA][(l * 2 + d) * 256 + ch]; bi[ni] = p->in[I_LRUBI][(l * 2 + d) * 256 + ch];
    const float lam = p->in[I_LRULAM][(l * 2 + d) * 256 + ch];
    const float x = __expf(-lam);
    const float sp = (x < 0.01f) ? x * (1.0f - x * (0.5f - x * (1.0f / 3.0f - 0.25f * x))) : __logf(1.0f + x);
    sp8[ni] = 8.0f * sp; H0[ni] = 0.f; P0[ni] = 1.f;
  }
  bf16_t* HL = (bf16_t*)(p->ws + BG_HL) + ((long)(b * 2 + d) * 2304 + 64 * q) * 256;
  bf16_t* PL = (bf16_t*)(p->ws + BG_PL) + ((long)(b * 2 + d) * 2304 + 64 * q) * 256;
#pragma unroll 1
  for (int mi = 0; mi < 4; ++mi) {
    bf16x8 xf[2];
#pragma unroll
    for (int kk = 0; kk < 2; ++kk) xf[kk] = *(LAS bf16x8*)((LAS unsigned char*)XB + (mi * 16 + fr) * 528 + (64 * h + kk * 32 + 8 * fq) * 2);
#pragma unroll
    for (int ni = 0; ni < 4; ++ni) {
      f32x4 aA = {0.f, 0.f, 0.f, 0.f}, aI = {0.f, 0.f, 0.f, 0.f};
      aA = __builtin_amdgcn_mfma_f32_16x16x32_bf16(xf[0], wa[ni][0], aA, 0, 0, 0);
      aA = __builtin_amdgcn_mfma_f32_16x16x32_bf16(xf[1], wa[ni][1], aA, 0, 0, 0);
      aI = __builtin_amdgcn_mfma_f32_16x16x32_bf16(xf[0], wi[ni][0], aI, 0, 0, 0);
      aI = __builtin_amdgcn_mfma_f32_16x16x32_bf16(xf[1], wi[ni][1], aI, 0, 0, 0);
      const int ch = 64 * h + 16 * ni + fr;
      float Ac[4], hl[4];
#pragma unroll
      for (int j = 0; j < 4; ++j) {
        const float xbv = bf2f(XB[(mi * 16 + 4 * fq + j) * 264 + ch]);
        const float r = sigmoidf_(aA[j] + ba[ni]), ig = sigmoidf_(aI[j] + bi[ni]);
        const float a = __expf(-sp8[ni] * r);
        const float bb = sqrtf(fmaxf(1.0f - a * a, 0.f)) * ig * xbv;
        if (j == 0) { Ac[0] = a; hl[0] = bb; } else { Ac[j] = a * Ac[j - 1]; hl[j] = a * hl[j - 1] + bb; }
      }
      float Ai = Ac[3], Bi = hl[3];
      { const float Ap = __shfl_up(Ai, 16), Bp = __shfl_up(Bi, 16); if (fq >= 1) { Bi = Ai * Bp + Bi; Ai = Ai * Ap; } }
      { const float Ap = __shfl_up(Ai, 32), Bp = __shfl_up(Bi, 32); if (fq >= 2) { Bi = Ai * Bp + Bi; Ai = Ai * Ap; } }
      float Ae = __shfl_up(Ai, 16), Be = __shfl_up(Bi, 16);
      if (fq == 0) { Ae = 1.f; Be = 0.f; }
      const float Hin = Ae * H0[ni] + Be, Pin = P0[ni] * Ae;
      float hf3 = 0.f, pf3 = 0.f;
#pragma unroll
      for (int j = 0; j < 4; ++j) {
        const float hf = Ac[j] * Hin + hl[j], pf = Pin * Ac[j];
        const long o = (long)(mi * 16 + 4 * fq + j) * 256 + ch;
        HL[o] = f2bf(hf); PL[o] = f2bf(pf);
        if (j == 3) { hf3 = hf; pf3 = pf; }
      }
      H0[ni] = __shfl(hf3, fr + 48); P0[ni] = __shfl(pf3, fr + 48);
    }
  }
  if (fq == 0) {
    float* AA = (float*)(p->ws + OFF_AGG) + ((long)(b * 2 + d) * 36 + q) * 256;
    float* AB = AA + 8 * 2 * 36 * 256;
#pragma unroll
    for (int ni = 0; ni < 4; ++ni) { AA[64 * h + 16 * ni + fr] = P0[ni]; AB[64 * h + 16 * ni + fr] = H0[ni]; }
  }
}

__device__ __forceinline__ void phase_mixer_prep(const Ctx& c, int l) {
  for (int it = c.blk; it < CVO_TOTAL; it += c.nblk) conv_item_O(c, l, it);
  for (int it = c.blk; it < 576; it += c.nblk) lru_scan_item(c, l, it);
  const int extra = (576 > c.nblk) ? 576 - c.nblk : 0, nrv = c.nblk - extra;
  for (int g = c.blk - extra; g >= 0 && g < NT / 32; g += nrv) {
    const int r0 = g * 32 + c.wid * 8;
    MixRowIn cur, nxt;
    mixer_row_load(c, r0, cur);
#pragma unroll 1
    for (int r = 0; r < 8; ++r) {
      if (r + 1 < 8) mixer_row_load(c, r0 + r + 1, nxt);
      mixer_row(c, l, r0 + r, cur);
      cur = nxt;
    }
  }
}

__device__ __forceinline__ void phase_mla_up(const Ctx& c, int l) {
  const KP p = c.p;
  const int lane = c.lane, wid = c.wid, fr = lane & 15, fq = lane >> 4, wr = wid >> 1, wc = wid & 1;
  const int nq = (NT / 128) * 3, nkv = (NT / 128) * 4;
  for (int it = c.blk; it < nq + nkv; it += c.nblk) {
    const bf16_t *ap[4], *bp[4]; f32x4 acc[4][4];
    if (it < nq) {
      const int mt = it / 3, nt = it % 3;
      rows_plain(c, (const bf16_t*)(p->ws + BG_DQN), 192, mt * 128, ap); rows_plain(c, (const bf16_t*)(p->ws + WT_WUQ), 192, nt * 128, bp);
      gemm_core(c, ap, bp, 3, 1, 0, 0, 0, 0, 0, 0, acc);
      const float qs = 0.10206207261596575f * LOG2E;
      const int G0 = 8 * nt + 4 * wc;
      const float* rc = (const float*)(p->ws + OFF_ROPE) + 2 * 2048 * 32; const float* rs = rc + 2048 * 16;
      bf16_t* QD = (bf16_t*)(p->ws + BG_QD);
#pragma unroll
      for (int m = 0; m < 4; ++m) {
        const int row = mt * 128 + wr * 64 + m * 16 + fr;
        const bool lat = row < NL; const int t = row & 2047;
#pragma unroll
        for (int n = 0; n < 4; ++n) {
          f32x4 v = acc[m][n];
          const int g6 = (G0 + n) % 6;
          if (lat && g6 == 4 && n < 3) {
            const f32x4 cs = *(const f32x4*)(rc + t * 16 + 4 * fq), sn = *(const f32x4*)(rs + t * 16 + 4 * fq);
            const f32x4 x1 = acc[m][n], x2 = acc[m][(n < 3) ? n + 1 : n];
            v = x1 * cs - x2 * sn;
          } else if (lat && g6 == 5 && n > 0) {
            const f32x4 cs = *(const f32x4*)(rc + t * 16 + 4 * fq), sn = *(const f32x4*)(rs + t * 16 + 4 * fq);
            const f32x4 x1 = acc[m][(n > 0) ? n - 1 : n], x2 = acc[m][n];
            v = x1 * sn + x2 * cs;
          }
          u32x2 w; w.x = pk2(v[0] * qs, v[1] * qs); w.y = pk2(v[2] * qs, v[3] * qs);
          *(u32x2*)(QD + (long)row * 384 + nt * 128 + wc * 64 + n * 16 + 4 * fq) = w;
        }
      }
    } else {
      const int i2 = it - nq, mt = i2 / 4, nt = i2 % 4;
      rows_plain(c, (const bf16_t*)(p->ws + BG_DKVN), 128, mt * 128, ap); rows_plain(c, (const bf16_t*)(p->ws + WT_WUKV), 128, nt * 128, bp);
      gemm_core(c, ap, bp, 2, 1, 0, 0, 0, 0, 0, 0, acc);
      bf16_t* base = wc == 0 ? (bf16_t*)(p->ws + BG_KD) + nt * 96 : (bf16_t*)(p->ws + BG_VD) + nt * 64;
      const long ld = wc == 0 ? 384 : 256;
#pragma unroll
      for (int m = 0; m < 4; ++m) {
        const int row = mt * 128 + wr * 64 + m * 16 + fr;
#pragma unroll
        for (int n = 0; n < 4; ++n) { u32x2 w; w.x = pk2(acc[m][n][0], acc[m][n][1]); w.y = pk2(acc[m][n][2], acc[m][n][3]); *(u32x2*)(base + (long)row * ld + n * 16 + 4 * fq) = w; }
      }
    }
  }
}

struct AttnSeg { const bf16_t* K; const bf16_t* V; int ntiles; int kabs0; };

template <int DQK>
__device__ __forceinline__ void attn_unit(const Ctx& c, const bf16_t* Q, int ldq, int ldk, int ldv, const AttnSeg s0, const AttnSeg s1, bool mask1, int qabs0,
                                          float m_init, float l_init, bf16_t* O) {
  constexpr int KS = DQK * 2 + 16, NKC = DQK / 8, NCH = 64 * NKC, NKR = (NCH + 511) / 512, NQF = DQK / 16, KBUF = 13312, VBASE = 26624;
  const int tid = c.ftid, lane = c.lane, wid = c.fwid, r32 = lane & 31, hi = lane >> 5;
  const bool g1 = wid >= 4;
  LAS unsigned char* lds = c.flds;
  bf16x8 qf[NQF];
  {
    const bf16_t* qp = Q + (long)(wid * 32 + r32) * ldq + hi * 8;
#pragma unroll
    for (int ks = 0; ks < NQF; ++ks) qf[ks] = *(const bf16x8*)(qp + ks * 16);
  }
  f32x16 o0, o1;
#pragma unroll
  for (int r = 0; r < 16; ++r) { o0[r] = 0.f; o1[r] = 0.f; }
  float m = m_init, lsum = (hi == 0) ? l_init : 0.f;
  const int ntot = s0.ntiles + s1.ntiles;
  u32x4 kreg[NKR], vreg[1];
  bf16x8 pf[2][2];
#define ATT_GLOAD(I) do { const int i_ = (I); const bool first_ = i_ < s0.ntiles; const int ii_ = first_ ? i_ : i_ - s0.ntiles; \
    const bf16_t* Kt_ = (first_ ? s0.K : s1.K) + (long)ii_ * 64 * ldk; \
    const bf16_t* Vt_ = (first_ ? s0.V : s1.V) + (long)ii_ * 64 * ldv; \
    _Pragma("unroll") for (int j_ = 0; j_ < NKR; ++j_) { const int id_ = tid + 512 * j_; if (id_ < NCH) kreg[j_] = *(const u32x4*)(Kt_ + (long)(id_ / NKC) * ldk + (id_ % NKC) * 8); } \
    { vreg[0] = *(const u32x4*)(Vt_ + (long)(tid >> 3) * ldv + (tid & 7) * 8); } } while (0)
#define ATT_LWRITE(KBI, VBI) do { LAS unsigned char* b_ = lds + (KBI) * KBUF; \
    _Pragma("unroll") for (int j_ = 0; j_ < NKR; ++j_) { const int id_ = tid + 512 * j_; if (id_ < NCH) *(LAS u32x4*)(b_ + (id_ / NKC) * KS + (id_ % NKC) * 16) = kreg[j_]; } \
    { const int key_ = tid >> 3, d8_ = tid & 7; \
      *(LAS u32x4*)(lds + VBASE + (VBI) * 8192 + ((key_ >> 3) * 2 + (d8_ >> 2)) * 512 + (key_ & 7) * 64 + (d8_ & 3) * 16) = vreg[0]; } } while (0)
#define ATT_PV(VBI) do { LAS unsigned char* vbp_ = lds + VBASE + (VBI) * 8192 + vb; \
    _Pragma("unroll") for (int dt = 0; dt < 2; ++dt) _Pragma("unroll") for (int t = 0; t < 2; ++t) _Pragma("unroll") for (int sp = 0; sp < 2; ++sp) { \
      const int kblk = 4 * t + 2 * sp; \
      const s16x4 lo = __builtin_bit_cast(s16x4, __builtin_amdgcn_ds_read_tr16_b64_v4i16((LAS s16x4*)(vbp_ + ((kblk + 0) * 2 + dt) * 512))); \
      const s16x4 hh = __builtin_bit_cast(s16x4, __builtin_amdgcn_ds_read_tr16_b64_v4i16((LAS s16x4*)(vbp_ + ((kblk + 1) * 2 + dt) * 512))); \
      const bf16x8 vf = (bf16x8){lo[0], lo[1], lo[2], lo[3], hh[0], hh[1], hh[2], hh[3]}; \
      if (dt == 0) o0 = __builtin_amdgcn_mfma_f32_32x32x16_bf16(vf, pf[t][sp], o0, 0, 0, 0); \
      else o1 = __builtin_amdgcn_mfma_f32_32x32x16_bf16(vf, pf[t][sp], o1, 0, 0, 0); \
      if (t == 1 && sp == 1) __builtin_amdgcn_sched_barrier(0); } } while (0)
  __syncthreads();
  ATT_GLOAD(0); ATT_LWRITE(0, 0);
  __syncthreads();
  const int vb = (4 * hi + ((lane & 15) >> 2)) * 64 + ((lane >> 4) & 1) * 32 + (lane & 3) * 8;
  int vcur = 0, vprev = 2;
  for (int i = 0; i < ntot; ++i) {
    if (i + 1 < ntot) ATT_GLOAD(i + 1);
    LAS unsigned char* kb = lds + (i & 1) * KBUF;
    if (g1 && i > 0) ATT_PV(vprev);
    __builtin_amdgcn_sched_barrier(0);
    f32x16 s[2];
    {
      bf16x8 kfa[NQF], kfb[NQF];
#pragma unroll
      for (int ks = 0; ks < NQF; ++ks) kfa[ks] = *(LAS bf16x8*)(kb + r32 * KS + (2 * ks + hi) * 16);
#pragma unroll
      for (int ks = 0; ks < NQF; ++ks) kfb[ks] = *(LAS bf16x8*)(kb + (32 + r32) * KS + (2 * ks + hi) * 16);
#pragma unroll
      for (int r = 0; r < 16; ++r) { s[0][r] = 0.f; s[1][r] = 0.f; }
      __builtin_amdgcn_sched_barrier(0);
#pragma unroll
      for (int ks = 0; ks < NQF; ++ks) s[0] = __builtin_amdgcn_mfma_f32_32x32x16_bf16(kfa[ks], qf[ks], s[0], 0, 0, 0);
#pragma unroll
      for (int ks = 0; ks < NQF; ++ks) s[1] = __builtin_amdgcn_mfma_f32_32x32x16_bf16(kfb[ks], qf[ks], s[1], 0, 0, 0);
      __builtin_amdgcn_sched_barrier(0);
    }
    if (mask1 && i >= s0.ntiles) {
      const int kbase = s1.kabs0 + (i - s0.ntiles) * 64, qa = qabs0 + wid * 32 + r32;
#pragma unroll
      for (int t = 0; t < 2; ++t)
#pragma unroll
        for (int r = 0; r < 16; ++r) { const int dd = kbase + 32 * t + crow(r, hi) - qa; if (dd > 128 || dd < -128) s[t][r] = -1e30f; }
    }
    float mxa = fmaxf(s[0][0], s[0][1]), mxb = fmaxf(s[0][2], s[0][3]), mxc = fmaxf(s[1][0], s[1][1]), mxd = fmaxf(s[1][2], s[1][3]);
#pragma unroll
    for (int r = 4; r < 16; r += 4) {
      mxa = fmaxf(fmaxf(mxa, s[0][r]), s[0][r + 1]); mxb = fmaxf(fmaxf(mxb, s[0][r + 2]), s[0][r + 3]);
      mxc = fmaxf(fmaxf(mxc, s[1][r]), s[1][r + 1]); mxd = fmaxf(fmaxf(mxd, s[1][r + 2]), s[1][r + 3]);
    }
    float mx = fmaxf(fmaxf(mxa, mxb), fmaxf(mxc, mxd));
    mx = fmaxf(mx, __shfl_xor(mx, 32));
    if (__any(mx > m + 8.0f)) {
      const float mnew = fmaxf(m, mx);
      const float alpha = __builtin_amdgcn_exp2f(m - mnew);
      m = mnew;
      lsum *= alpha;
#pragma unroll
      for (int r = 0; r < 16; ++r) { o0[r] *= alpha; o1[r] *= alpha; }
    }
    float ps0 = 0.f, ps1 = 0.f, ps2 = 0.f, ps3 = 0.f;
#pragma unroll
    for (int t = 0; t < 2; ++t)
#pragma unroll
      for (int r = 0; r < 16; r += 4) {
        s[t][r] = __builtin_amdgcn_exp2f(s[t][r] - m); s[t][r + 1] = __builtin_amdgcn_exp2f(s[t][r + 1] - m);
        s[t][r + 2] = __builtin_amdgcn_exp2f(s[t][r + 2] - m); s[t][r + 3] = __builtin_amdgcn_exp2f(s[t][r + 3] - m);
        ps0 += s[t][r]; ps1 += s[t][r + 1]; ps2 += s[t][r + 2]; ps3 += s[t][r + 3];
      }
    lsum += (ps0 + ps1) + (ps2 + ps3);
    __builtin_amdgcn_sched_barrier(0);
#pragma unroll
    for (int t = 0; t < 2; ++t)
#pragma unroll
      for (int sp = 0; sp < 2; ++sp) {
        u32x4 w; w.x = pk2(s[t][8 * sp + 0], s[t][8 * sp + 1]); w.y = pk2(s[t][8 * sp + 2], s[t][8 * sp + 3]);
        w.z = pk2(s[t][8 * sp + 4], s[t][8 * sp + 5]); w.w = pk2(s[t][8 * sp + 6], s[t][8 * sp + 7]);
        pf[t][sp] = __builtin_bit_cast(bf16x8, w);
      }
    __builtin_amdgcn_sched_barrier(0);
    if (!g1) ATT_PV(vcur);
    const int vnext = (vcur == 2) ? 0 : vcur + 1;
    if (i + 1 < ntot) ATT_LWRITE((i + 1) & 1, vnext);
    vprev = vcur; vcur = vnext;
    __syncthreads();
  }
  if (g1) ATT_PV(vprev);
  const float ltot = lsum + __shfl_xor(lsum, 32);
  const float inv = 1.0f / ltot;
  bf16_t* orow = O + (long)(wid * 32 + r32) * D;
#pragma unroll
  for (int g = 0; g < 4; ++g) {
    u32x2 w0, w1;
    w0.x = pk2(o0[4 * g] * inv, o0[4 * g + 1] * inv); w0.y = pk2(o0[4 * g + 2] * inv, o0[4 * g + 3] * inv);
    w1.x = pk2(o1[4 * g] * inv, o1[4 * g + 1] * inv); w1.y = pk2(o1[4 * g + 2] * inv, o1[4 * g + 3] * inv);
    *(u32x2*)(orow + 8 * g + 4 * hi) = w0;
    *(u32x2*)(orow + 32 + 8 * g + 4 * hi) = w1;
  }
#undef ATT_GLOAD
#undef ATT_LWRITE
#undef ATT_PV
}

template <int type>
__device__ __forceinline__ void attn_dispatch(const Ctx& c, int l, int b, int hq, int qb, bool ctxq) {
  const KP p = c.p;
  const bf16_t* PROJ = (const bf16_t*)(p->ws + BG_PROJ);
  bf16_t* YMIX = (bf16_t*)(p->ws + BG_YMIX);
  const int rowq0 = ctxq ? NL + b * CL : b * SEQ + qb * 256;
  const long crow0 = NL + b * CL, lrow0 = (long)b * SEQ;
  if constexpr (type == 0) {
    const bf16_t* QD = (const bf16_t*)(p->ws + BG_QD); const bf16_t* KD = (const bf16_t*)(p->ws + BG_KD); const bf16_t* VD = (const bf16_t*)(p->ws + BG_VD);
    AttnSeg s0{KD + crow0 * 384 + hq * 96, VD + crow0 * 256 + hq * 64, 4, 0};
    AttnSeg s1{KD + lrow0 * 384 + hq * 96, VD + lrow0 * 256 + hq * 64, ctxq ? 0 : 32, 0};
    attn_unit<96>(c, QD + (long)rowq0 * 384 + hq * 96, 384, 384, 256, s0, s1, false, 0, -1e30f, 0.f, YMIX + (long)rowq0 * D + 768 + hq * 64);
  } else if constexpr (type == 1) {
    const int g = hq >> 1;
    AttnSeg s0{PROJ + crow0 * PLD + cAK + g * 64, PROJ + crow0 * PLD + cAV + g * 64, 4, 0};
    AttnSeg s1{PROJ + lrow0 * PLD + cAK + g * 64, PROJ + lrow0 * PLD + cAV + g * 64, ctxq ? 0 : 32, 0};
    attn_unit<64>(c, PROJ + (long)rowq0 * PLD + cAQ + hq * 64, PLD, PLD, PLD, s0, s1, false, 0, -1e30f, 0.f, YMIX + (long)rowq0 * D + hq * 64);
  } else {
    const int g = hq >> 1;
    const float sink = p->in[I_CSINK][l * 4 + hq] * LOG2E;
    AttnSeg s0{PROJ + crow0 * PLD + cCK + g * 64, PROJ + crow0 * PLD + cCV + g * 64, 4, 0};
    int k0 = qb * 256 - 128, k1 = qb * 256 + 384; if (k0 < 0) k0 = 0; if (k1 > SEQ) k1 = SEQ;
    AttnSeg s1{PROJ + (lrow0 + k0) * PLD + cCK + g * 64, PROJ + (lrow0 + k0) * PLD + cCV + g * 64, ctxq ? 0 : (k1 - k0) / 64, k0};
    attn_unit<64>(c, PROJ + (long)rowq0 * PLD + cCQ + hq * 64, PLD, PLD, PLD, s0, s1, true, qb * 256, sink, 1.0f, YMIX + (long)rowq0 * D + 512 + hq * 64);
  }
}

__device__ __forceinline__ void unpack8(const u32x4 w, float (&f)[8]) {
  f[0] = __uint_as_float(w.x << 16); f[1] = __uint_as_float(w.x & 0xffff0000u); f[2] = __uint_as_float(w.y << 16); f[3] = __uint_as_float(w.y & 0xffff0000u);
  f[4] = __uint_as_float(w.z << 16); f[5] = __uint_as_float(w.z & 0xffff0000u); f[6] = __uint_as_float(w.w << 16); f[7] = __uint_as_float(w.w & 0xffff0000u);
}
__device__ __forceinline__ void lru_fix_item(const Ctx& c, int b, bool isctx, int ch64) {
  const KP p = c.p; const int og = c.tid & 31, pg = c.tid >> 5, ch = og * 8;
  const int q0 = isctx ? ch64 : 4 + ch64;
  const int q1 = isctx ? 3 - ch64 : 35 - ch64;
  const float* AA = (const float*)(p->ws + OFF_AGG); const float* AB = AA + 8 * 2 * 36 * 256;
  float c0[8], c1[8];
#pragma unroll
  for (int e = 0; e < 8; ++e) { c0[e] = 0.f; c1[e] = 0.f; }
#pragma unroll 4
  for (int q = 0; q < q0; ++q) {
    const long o = ((long)(b * 2 + 0) * 36 + q) * 256 + ch;
    const f32x4 a0 = *(const f32x4*)(AA + o), a1 = *(const f32x4*)(AA + o + 4), b0 = *(const f32x4*)(AB + o), b1 = *(const f32x4*)(AB + o + 4);
#pragma unroll
    for (int e = 0; e < 4; ++e) { c0[e] = a0[e] * c0[e] + b0[e]; c0[4 + e] = a1[e] * c0[4 + e] + b1[e]; }
  }
#pragma unroll 4
  for (int q = 0; q < q1; ++q) {
    const long o = ((long)(b * 2 + 1) * 36 + q) * 256 + ch;
    const f32x4 a0 = *(const f32x4*)(AA + o), a1 = *(const f32x4*)(AA + o + 4), b0 = *(const f32x4*)(AB + o), b1 = *(const f32x4*)(AB + o + 4);
#pragma unroll
    for (int e = 0; e < 4; ++e) { c1[e] = a0[e] * c1[e] + b0[e]; c1[4 + e] = a1[e] * c1[4 + e] + b1[e]; }
  }
  const bf16_t* HL0 = (const bf16_t*)(p->ws + BG_HL) + ((long)(b * 2 + 0) * 2304 + 64 * q0) * 256 + ch;
  const bf16_t* PL0 = (const bf16_t*)(p->ws + BG_PL) + ((long)(b * 2 + 0) * 2304 + 64 * q0) * 256 + ch;
  const bf16_t* HL1 = (const bf16_t*)(p->ws + BG_HL) + ((long)(b * 2 + 1) * 2304 + 64 * q1) * 256 + ch;
  const bf16_t* PL1 = (const bf16_t*)(p->ws + BG_PL) + ((long)(b * 2 + 1) * 2304 + 64 * q1) * 256 + ch;
  const long row0 = isctx ? NL + b * CL + ch64 * 64 : (long)b * SEQ + ch64 * 64;
  const bf16_t* bg = (const bf16_t*)(p->ws + BG_PROJ) + row0 * PLD + cBG + ch;
  bf16_t* y = (bf16_t*)(p->ws + BG_YMIX) + row0 * D + 256 + ch;
#pragma unroll 4
  for (int ii = 0; ii < 8; ++ii) {
    const int i = pg * 8 + ii;
    float h0[8], p0[8], h1[8], p1[8], g[8];
    unpack8(*(const u32x4*)(HL0 + (long)i * 256), h0); unpack8(*(const u32x4*)(PL0 + (long)i * 256), p0);
    unpack8(*(const u32x4*)(HL1 + (long)(63 - i) * 256), h1); unpack8(*(const u32x4*)(PL1 + (long)(63 - i) * 256), p1);
    unpack8(*(const u32x4*)(bg + (long)i * PLD), g);
    float o[8];
#pragma unroll
    for (int e = 0; e < 8; ++e) o[e] = (h0[e] + p0[e] * c0[e] + h1[e] + p1[e] * c1[e]) * gelu_tanh(g[e]);
    u32x4 w; w.x = pk2(o[0], o[1]); w.y = pk2(o[2], o[3]); w.z = pk2(o[4], o[5]); w.w = pk2(o[6], o[7]);
    *(u32x4*)(y + (long)i * D) = w;
  }
}

__device__ __forceinline__ void phase_mixers(const Ctx& c, int l) {
  for (int u = c.fblk; u < 256; u += c.fnblk) { const int b = u & 7, r = u >> 3; attn_dispatch<0>(c, l, b, r >> 3, r & 7, false); }
  for (int u = c.fblk; u < 256; u += c.fnblk) { const int b = u & 7, r = u >> 3; attn_dispatch<1>(c, l, b, r >> 3, r & 7, false); }
  for (int u = c.fblk; u < 256; u += c.fnblk) { const int b = u & 7, r = u >> 3; attn_dispatch<2>(c, l, b, r >> 3, r & 7, false); }
  for (int i2 = c.blk; i2 < 256; i2 += c.nblk) lru_fix_item(c, i2 >> 5, false, i2 & 31);
  if (l == 0) {
    for (int u = c.fnblk - 1 - c.fblk; u < 32; u += c.fnblk) attn_dispatch<0>(c, l, u & 7, u >> 3, 0, true);
    for (int u = c.fnblk - 33 - c.fblk; u < 32; u += c.fnblk) if (u >= 0) attn_dispatch<1>(c, l, u & 7, u >> 3, 0, true);
    for (int u = c.fnblk - 65 - c.fblk; u < 32; u += c.fnblk) if (u >= 0) attn_dispatch<2>(c, l, u & 7, u >> 3, 0, true);
    for (int i2 = c.nblk - 1 - c.blk; i2 < 32; i2 += c.nblk) lru_fix_item(c, i2 >> 2, true, i2 & 3);
  }
}

__device__ __forceinline__ void phase_outproj(const Ctx& c, int nrows) {
  plain_gemm8(c, (const bf16_t*)(c.p->ws + BG_YMIX), (const bf16_t*)(c.p->ws + WT_WOUT), (bf16_t*)(c.p->ws + BG_YOUT), D, D, D, nrows / 256, 4, D, 16);
}

__device__ __forceinline__ void phase_postmix(const Ctx& c, int l, int nrows) {
  const KP p = c.p;
  const int gw = c.blk * 4 + c.wid, ngw = c.nblk * 4;
  for (int row = gw; row < nrows; row += ngw) {
    const float* xr = (l == 0) ? xin_row(c, row) : xs_row(c, row);
    float* xo = xs_row(c, row);
    const bf16_t* yr = (const bf16_t*)(p->ws + BG_YOUT) + (long)row * D;
    const float* md = mod_ptr(c, l, row);
    f32x4 y[4], x[4]; float ss = 0.f;
#pragma unroll
    for (int j = 0; j < 4; ++j) {
      const u32x2 w = *(const u32x2*)(yr + 256 * j + 4 * c.lane);
      { float a, b, cc, d; unpack4(w, a, b, cc, d); y[j] = (f32x4){a, b, cc, d}; }
      ss += y[j][0] * y[j][0] + y[j][1] * y[j][1] + y[j][2] * y[j][2] + y[j][3] * y[j][3];
      x[j] = *(const f32x4*)(xr + 256 * j + 4 * c.lane);
    }
    const float rs = rsqrtf(wave_sum(ss) * (1.0f / D) + EPS);
#pragma unroll
    for (int j = 0; j < 4; ++j) {
      const int e = 256 * j + 4 * c.lane;
      const f32x4 g = *(const f32x4*)(p->in[I_GPOSTMIX] + l * D + e), g1 = *(const f32x4*)(md + 2048 + e);
      x[j] = x[j] + g1 * (y[j] * rs * g);
      *(f32x4*)(xo + e) = x[j];
    }
    norm_mod_store(c, x, p->in[I_GPREFFN] + l * D, md + 3072, md + 4096, (bf16_t*)(p->ws + BG_VHI) + (long)row * D, (bf16_t*)(p->ws + BG_VLO) + (long)row * D);
  }
}

__device__ __forceinline__ void phase_router(const Ctx& c, int l, int ntok) {
  const KP p = c.p;
  const int lane = c.lane, wid = c.wid, fr = lane & 15, fq = lane >> 4, wr = wid >> 1, wc = wid & 1, tid = c.tid;
  const int ntile = ntok / 128;
  LAS float* LG = (LAS float*)c.flds;
  LAS float* LG1 = (LAS float*)(c.flds + 65536);
  LAS float* BIAS = LG + 128 * 65;
  LAS int* HIST = (LAS int*)(BIAS + 64);
  const bool h0 = c.hb == 0;
  constexpr int CVE_IDLE = 2600;
  if (c.fnblk > ntile && c.fblk >= ntile) {
    const int vb = c.blk - 2 * ntile, nvb = c.nblk - 2 * ntile;
    for (int it = vb; it < CVE_IDLE; it += nvb) conv_item_E(c, l, it);
    return;
  }
  for (int it = c.fblk; it < ntile; it += c.fnblk) {
    const bf16_t *ap[4], *bp[4]; f32x4 acc[4][4];
    rows_plain(c, (const bf16_t*)(p->ws + BG_VHI), D, it * 128, ap); rows_plain(c, (const bf16_t*)(p->ws + WT_RHI), D, 0, bp);
    const long alo = (long)(BG_VLO - BG_VHI) / 2, blo = (long)(WT_RLO - WT_RHI) / 2, ho = (long)c.hb * 512;
    gemm_core(c, ap, bp, 8, 3, ho, alo + ho, ho, ho, ho, blo + ho, acc);
    if (!h0 && wc == 0) {
#pragma unroll
      for (int m = 0; m < 4; ++m)
#pragma unroll
        for (int n = 0; n < 4; ++n)
#pragma unroll
          for (int j = 0; j < 4; ++j) LG1[(wr * 64 + m * 16 + fr) * 65 + n * 16 + 4 * fq + j] = acc[m][n][j];
    }
    __syncthreads();
    if (h0 && wc == 0) {
#pragma unroll
      for (int m = 0; m < 4; ++m)
#pragma unroll
        for (int n = 0; n < 4; ++n)
#pragma unroll
          for (int j = 0; j < 4; ++j) { const int ix = (wr * 64 + m * 16 + fr) * 65 + n * 16 + 4 * fq + j; LG[ix] = acc[m][n][j] + LG1[ix]; }
    }
    if (h0 && tid < 64) { BIAS[tid] = p->in[I_RB][l * 64 + tid]; HIST[tid] = 0; }
    __syncthreads();
    if (h0 && tid < 128) {
      LAS float* lg = LG + tid * 65;
      for (int e = 0; e < 64; ++e) lg[e] = 1.0f / (1.0f + __expf(-lg[e]));
      float gs[8];
#pragma unroll
      for (int g = 0; g < 8; ++g) {
        float m1 = -INFINITY, m2 = -INFINITY;
        for (int e = 0; e < 8; ++e) { const float v = lg[g * 8 + e] + BIAS[g * 8 + e]; if (v > m1) { m2 = m1; m1 = v; } else if (v > m2) m2 = v; }
        gs[g] = m1 + m2;
      }
      unsigned gmask = 0;
#pragma unroll
      for (int k = 0; k < 4; ++k) {
        float best = -INFINITY; int bi = 0;
#pragma unroll
        for (int g = 0; g < 8; ++g) { const bool ok = !((gmask >> g) & 1u) && gs[g] > best; if (ok) { best = gs[g]; bi = g; } }
        gmask |= 1u << bi;
      }
      unsigned long long chosen = 0ull; float wsum = 0.f; int idx[8]; float wv[8];
#pragma unroll
      for (int k = 0; k < 8; ++k) {
        float best = -INFINITY; int bi = 0;
        for (int e = 0; e < 64; ++e) {
          const bool ok = ((gmask >> (e >> 3)) & 1u) && !((chosen >> e) & 1ull);
          const float v = lg[e] + BIAS[e];
          if (ok && v > best) { best = v; bi = e; }
        }
        chosen |= 1ull << bi; idx[k] = bi; wv[k] = lg[bi]; wsum += wv[k];
      }
      const float sc = 2.5f / wsum;
      const int tok = it * 128 + tid;
      int* oi = (int*)(p->ws + RT_IDX) + (long)tok * 8; float* ow = (float*)(p->ws + RT_W) + (long)tok * 8;
#pragma unroll
      for (int k = 0; k < 8; ++k) { oi[k] = idx[k]; ow[k] = wv[k] * sc; atomicAdd((int*)&HIST[idx[k]], 1); }
    }
    __syncthreads();
    if (h0 && tid < 64) ((int*)(p->ws + RT_TCNT))[it * 64 + tid] = HIST[tid];
    __syncthreads();
  }
  if (c.fnblk <= ntile) { for (int it = c.blk; it < CVE_TOTAL; it += c.nblk) conv_item_E(c, l, it); }
  else { for (int it = CVE_IDLE + c.blk; it < CVE_TOTAL; it += 2 * ntile) conv_item_E(c, l, it); }
}

__device__ __forceinline__ void phase_positions(const Ctx& c, int ntok) {
  const KP p = c.p; const int tid = c.tid; const int ntile = ntok / 128;
  LAS int* TOT = (LAS int*)c.lds; LAS int* PRE = TOT + 64; LAS int* BASE = PRE + 64; LAS unsigned* SEL = (LAS unsigned*)(BASE + 64);
  const int* tc = (const int*)(p->ws + RT_TCNT);
  for (int it = c.blk; it < ntile; it += c.nblk) {
    __syncthreads();
    {
      LAS int* T4 = (LAS int*)(SEL + 256); LAS int* P4 = T4 + 256;
      const int e = tid & 63, part = tid >> 6;
      int tot = 0, pre = 0;
#pragma unroll 4
      for (int t = part; t < ntile; t += 4) { const int v = tc[t * 64 + e]; tot += v; if (t < it) pre += v; }
      T4[part * 64 + e] = tot; P4[part * 64 + e] = pre;
      SEL[tid] = 0u;
      __syncthreads();
      if (tid < 64) { TOT[tid] = T4[tid] + T4[64 + tid] + T4[128 + tid] + T4[192 + tid]; PRE[tid] = P4[tid] + P4[64 + tid] + P4[128 + tid] + P4[192 + tid]; }
    }
    __syncthreads();
    if (tid < 64) {
      int off = 0;
      for (int e = 0; e < tid; ++e) off += TOT[e];
      BASE[tid] = off + PRE[tid];
      if (it == 0) { ((int*)(p->ws + RT_EOFF))[tid] = off; ((int*)(p->ws + RT_ECNT))[tid] = TOT[tid]; }
    }
    const int tok = it * 128 + tid;
    int idx[8];
    if (tid < 128) {
      const int* ii = (const int*)(p->ws + RT_IDX) + (long)tok * 8;
#pragma unroll
      for (int k = 0; k < 8; ++k) { idx[k] = ii[k]; atomicOr((unsigned*)&SEL[idx[k] * 4 + (tid >> 5)], 1u << (tid & 31)); }
    }
    __syncthreads();
    if (tid < 128) {
      const float* ww = (const float*)(p->ws + RT_W) + (long)tok * 8;
      const int w = tid >> 5; const unsigned below = (1u << (tid & 31)) - 1u;
#pragma unroll
      for (int k = 0; k < 8; ++k) {
        const int e = idx[k];
        int rank = __popc(SEL[e * 4 + w] & below);
        for (int q = 0; q < w; ++q) rank += __popc(SEL[e * 4 + q]);
        const int pos = BASE[e] + rank;
        ((int*)(p->ws + RT_LTOK))[pos] = tok; ((float*)(p->ws + RT_LW))[pos] = ww[k]; ((int*)(p->ws + RT_POSMAP))[(long)tok * 8 + k] = pos;
      }
    }
  }
}

__device__ __forceinline__ int build_tiles(const Ctx& c, int ntok, LAS int* TAB) {
  __syncthreads();
  if (c.ftid < 64) { TAB[c.ftid] = ((const int*)(c.p->ws + RT_ECNT))[c.ftid]; TAB[64 + c.ftid] = ((const int*)(c.p->ws + RT_EOFF))[c.ftid]; }
  __syncthreads();
  if (c.ftid == 0) {
    const int x = c.fblk & 7; int s = 0;
#pragma unroll 1
    for (int k = 0; k < 8; ++k) { TAB[128 + k] = s; s += (TAB[x + 8 * k] + 255) >> 8; }
    TAB[136] = s; s += (ntok / 256) / 8; TAB[137] = s;
  }
  __syncthreads();
  return TAB[137];
}
__device__ __forceinline__ void find_local(LAS const int* TAB, int x, int ntok, int tile, int& e, int& rt) {
  int k = 0;
#pragma unroll 1
  for (int q = 1; q < 9; ++q) if (TAB[128 + q] <= tile) k = q;
  if (k < 8) { e = x + 8 * k; rt = tile - TAB[128 + k]; } else { e = 64; rt = x * ((ntok / 256) / 8) + (tile - TAB[136]); }
}

struct GateUpF {
  LAS const int* CUM; const int* ltok; const bf16_t* V; const bf16_t* W; bf16_t* H; int atot, ftid, lane, fwid, xg, ntok;
  int pe, pcnt, phrow0, ptok[4];
  __device__ __forceinline__ void pre(int it) {
    const int tile = it >> 1; int e, rt; find_local(CUM, xg, ntok, tile, e, rt);
    int cnt, hrow0;
    if (e < 64) { cnt = CUM[e] - rt * 256; if (cnt > 256) cnt = 256; hrow0 = CUM[64 + e] + rt * 256; } else { cnt = 256; hrow0 = atot + rt * 256; }
#pragma unroll
    for (int i = 0; i < 4; ++i) { const int r = stage_row8(ftid, i); ptok[i] = (e < 64) ? ltok[hrow0 + ((r < cnt) ? r : 0)] : rt * 256 + r; }
    pe = e; pcnt = cnt; phrow0 = hrow0;
  }
  __device__ __forceinline__ const bf16_t* Abase() const { return V; }
  __device__ __forceinline__ const bf16_t* Bbase() const { return W; }
  __device__ __forceinline__ ItemInfo setup(int it, unsigned (&ap)[4], unsigned (&bp)[4]) {
    const int nt = it & 1; const int co = stage_coff(ftid);
#pragma unroll
    for (int i = 0; i < 4; ++i) { ap[i] = (unsigned)(ptok[i] * D + co); bp[i] = (unsigned)((pe * 512 + nt * 256 + stage_row8(ftid, i)) * D + co); }
    return ItemInfo{pe, pcnt, phrow0, nt};
  }
  __device__ __forceinline__ void epi(const ItemInfo& ii, const f32x4 (&acc)[4][8]) {
    const int fr = lane & 15, fq = lane >> 4, wr = fwid >> 1, wc = fwid & 1;
#pragma unroll
    for (int m = 0; m < 4; ++m) {
      const int rl = wr * 64 + m * 16 + fr;
      if (rl < ii.b) {
        bf16_t* hp = H + (long)(ii.c + rl) * 256 + 32 * (ii.d * 4 + wc * 2) + 4 * fq;
#pragma unroll
        for (int g2 = 0; g2 < 2; ++g2)
#pragma unroll
          for (int n = 0; n < 2; ++n) {
            float hv[4];
#pragma unroll
            for (int j = 0; j < 4; ++j) { const float g = acc[m][g2 * 4 + n][j], u = acc[m][g2 * 4 + n + 2][j]; hv[j] = g / (1.0f + __expf(-g)) * u; }
            u32x2 w; w.x = pk2(hv[0], hv[1]); w.y = pk2(hv[2], hv[3]);
            *(u32x2*)(hp + 32 * g2 + 16 * n) = w;
          }
      }
    }
  }
};
__device__ __forceinline__ void phase_gateup(const Ctx& c, int ntok) {
  const KP p = c.p;
  LAS int* CUM = (LAS int*)(c.flds + LDS_TAB);
  const int ntiles = build_tiles(c, ntok, CUM);
  GateUpF f{CUM, (const int*)(p->ws + RT_LTOK), (const bf16_t*)(p->ws + BG_VHI),
            (const bf16_t*)(p->ws + WT_WGU), (bf16_t*)(p->ws + OFF_UH), ntok * 8, c.ftid, c.lane, c.fwid, c.fblk & 7, ntok, 0, 0, 0, {0, 0, 0, 0}};
  gemm8_persistent<8>(c, c.fblk >> 3, c.fnblk >> 3, ntiles * 2, 16, f);
}

struct DownF {
  LAS const int* CUM; const float* lw; const bf16_t* H; const bf16_t* W; bf16_t* Y; int atot, ftid, lane, fwid, xg, ntok;
  int pe, pcnt, phrow0;
  __device__ __forceinline__ void pre(int it) {
    const int tile = it >> 2; int e, rt; find_local(CUM, xg, ntok, tile, e, rt);
    int cnt, hrow0;
    if (e < 64) { cnt = CUM[e] - rt * 256; if (cnt > 256) cnt = 256; hrow0 = CUM[64 + e] + rt * 256; } else { cnt = 256; hrow0 = atot + rt * 256; }
    pe = e; pcnt = cnt; phrow0 = hrow0;
  }
  __device__ __forceinline__ const bf16_t* Abase() const { return H; }
  __device__ __forceinline__ const bf16_t* Bbase() const { return W; }
  __device__ __forceinline__ ItemInfo setup(int it, unsigned (&ap)[4], unsigned (&bp)[4]) {
    const int nt = it & 3; const int co = stage_coff(ftid);
#pragma unroll
    for (int i = 0; i < 4; ++i) { int r = stage_row8(ftid, i); if (r >= pcnt) r = 0; ap[i] = (unsigned)((phrow0 + r) * 256 + co); bp[i] = (unsigned)((pe * 1024 + nt * 256 + stage_row8(ftid, i)) * 256 + co); }
    return ItemInfo{pe, pcnt, phrow0, nt};
  }
  __device__ __forceinline__ void epi(const ItemInfo& ii, const f32x4 (&acc)[4][8]) {
    const int fr = lane & 15, fq = lane >> 4, wr = fwid >> 1, wc = fwid & 1;
#pragma unroll
    for (int m = 0; m < 4; ++m) {
      const int rl = wr * 64 + m * 16 + fr;
      if (rl < ii.b) {
        const float sc = (ii.a < 64) ? lw[ii.c + rl] : 1.0f;
        bf16_t* yp = Y + (long)(ii.c + rl) * D + ii.d * 256 + wc * 128 + 4 * fq;
#pragma unroll
        for (int n = 0; n < 8; ++n) { u32x2 w; w.x = pk2(acc[m][n][0] * sc, acc[m][n][1] * sc); w.y = pk2(acc[m][n][2] * sc, acc[m][n][3] * sc); *(u32x2*)(yp + n * 16) = w; }
      }
      __builtin_amdgcn_sched_barrier(0);
    }
  }
};
__device__ __forceinline__ void phase_down(const Ctx& c, int ntok) {
  const KP p = c.p;
  LAS int* CUM = (LAS int*)(c.flds + LDS_TAB);
  const int ntiles = build_tiles(c, ntok, CUM);
  DownF f{CUM, (const float*)(p->ws + RT_LW), (const bf16_t*)(p->ws + OFF_UH),
          (const bf16_t*)(p->ws + WT_WD), (bf16_t*)(p->ws + BG_Y), ntok * 8, c.ftid, c.lane, c.fwid, c.fblk & 7, ntok, 0, 0, 0};
  gemm8_persistent<8>(c, c.fblk >> 3, c.fnblk >> 3, ntiles * 4, 4, f);
}

__device__ __forceinline__ void phase_combine(const Ctx& c, int l, int ntok) {
  const KP p = c.p;
  const int gw = c.blk * 4 + c.wid, ngw = c.nblk * 4, lane = c.lane;
  const bf16_t* Y = (const bf16_t*)(p->ws + BG_Y); const int* pm = (const int*)(p->ws + RT_POSMAP);
  const long atot = (long)ntok * 8;
  for (int row = gw; row < ntok; row += ngw) {
    int pos[8];
    { const int4 a = *(const int4*)(pm + (long)row * 8), b = *(const int4*)(pm + (long)row * 8 + 4);
      pos[0] = a.x; pos[1] = a.y; pos[2] = a.z; pos[3] = a.w; pos[4] = b.x; pos[5] = b.y; pos[6] = b.z; pos[7] = b.w; }
    u32x4 yv[9][2];
#pragma unroll
    for (int k = 0; k < 9; ++k) {
      const long yr = (k < 8) ? (long)pos[k] : atot + row;
      const bf16_t* yp = Y + yr * D + 8 * lane;
      yv[k][0] = *(const u32x4*)(yp); yv[k][1] = *(const u32x4*)(yp + 512);
    }
    float* xo = xs_row(c, row);
    f32x4 xv[2][2];
#pragma unroll
    for (int j = 0; j < 2; ++j) { xv[j][0] = *(const f32x4*)(xo + 512 * j + 8 * lane); xv[j][1] = *(const f32x4*)(xo + 512 * j + 8 * lane + 4); }
    float f[2][8];
#pragma unroll
    for (int j = 0; j < 2; ++j) {
#pragma unroll
      for (int i = 0; i < 8; ++i) f[j][i] = 0.f;
#pragma unroll
      for (int k = 0; k < 9; ++k) { float t8[8]; unpack8(yv[k][j], t8);
#pragma unroll
        for (int i = 0; i < 8; ++i) f[j][i] += t8[i]; }
    }
    float ss = 0.f;
#pragma unroll
    for (int j = 0; j < 2; ++j)
#pragma unroll
      for (int i = 0; i < 8; ++i) ss += f[j][i] * f[j][i];
    const float rs = rsqrtf(wave_sum(ss) * (1.0f / D) + EPS);
    const float* md = mod_ptr(c, l, row);
    float x[2][8]; float ss2 = 0.f;
#pragma unroll
    for (int j = 0; j < 2; ++j) {
      const int e = 512 * j + 8 * lane;
#pragma unroll
      for (int h = 0; h < 2; ++h) {
        const f32x4 g = *(const f32x4*)(p->in[I_GPOSTFFN] + l * D + e + 4 * h), g2 = *(const f32x4*)(md + 5120 + e + 4 * h);
        f32x4 o;
#pragma unroll
        for (int i = 0; i < 4; ++i) { o[i] = xv[j][h][i] + g2[i] * (f[j][4 * h + i] * rs * g[i]); x[j][4 * h + i] = o[i]; ss2 += o[i] * o[i]; }
        *(f32x4*)(xo + e + 4 * h) = o;
      }
    }
    if (l == 0) {
      const float rs2 = rsqrtf(wave_sum(ss2) * (1.0f / D) + EPS);
      const float* md1 = mod_ptr(c, 1, row);
      bf16_t* uo = (bf16_t*)(p->ws + OFF_UH) + (long)row * D;
#pragma unroll
      for (int j = 0; j < 2; ++j) {
        const int e = 512 * j + 8 * lane;
        float u[8];
#pragma unroll
        for (int h = 0; h < 2; ++h) {
          const f32x4 g = *(const f32x4*)(p->in[I_GPREMIX] + D + e + 4 * h), shv = *(const f32x4*)(md1 + e + 4 * h), scv = *(const f32x4*)(md1 + 1024 + e + 4 * h);
#pragma unroll
          for (int i = 0; i < 4; ++i) u[4 * h + i] = (x[j][4 * h + i] * rs2 * g[i]) * (1.0f + scv[i]) + shv[i];
        }
        u32x4 w; w.x = pk2(u[0], u[1]); w.y = pk2(u[2], u[3]); w.z = pk2(u[4], u[5]); w.w = pk2(u[6], u[7]);
        *(u32x4*)(uo + e) = w;
      }
    }
  }
}

#define XB_TMO      128
#define XB_XCNT(j)  (256  + 64 * (j))
#define XB_XSUB(j)  (1280 + 64 * (j))
#define XB_XGEN(j)  (2304 + 64 * (j))
#define XB_TOP      3328
#define XB_TOPGEN   3392
#define XCD_BAR_WORDS 3456
#define XB_SPIN_CAP (1u << 20)
__device__ __forceinline__ unsigned xb_ld(unsigned* p)              { return __hip_atomic_load(p, __ATOMIC_RELAXED, __HIP_MEMORY_SCOPE_AGENT); }
__device__ __forceinline__ unsigned xb_add(unsigned* p, unsigned v) { return __hip_atomic_fetch_add(p, v, __ATOMIC_RELAXED, __HIP_MEMORY_SCOPE_AGENT); }
__device__ __forceinline__ unsigned xb_xcc_id() { return (unsigned)__builtin_amdgcn_s_getreg((3 << 11) | 20) & 0xFu; }
#define XB_SPIN(cond, bar) do { unsigned _sp = 0; while (cond) { __builtin_amdgcn_s_sleep(1); \
    if ((++_sp & 255u) == 0u) { if (xb_ld(&(bar)[XB_TMO])) break; if (_sp > XB_SPIN_CAP) { atomicAdd(&(bar)[XB_TMO], 1u); break; } } } } while (0)
struct XcdBarrier { unsigned* bar; unsigned x; volatile LAS unsigned* st; };
__device__ __forceinline__ XcdBarrier xcd_barrier_post(unsigned* bar, volatile LAS unsigned* st) {
  XcdBarrier b; b.bar = bar; b.x = xb_xcc_id(); b.st = st;
  if (threadIdx.x == 0) (void)xb_add(&bar[XB_XCNT(b.x)], 1u);
  return b;
}
__device__ __forceinline__ void xcd_barrier_complete(unsigned* bar, unsigned x, unsigned& nloc, unsigned& nx) {
  const unsigned G = gridDim.x * gridDim.y * gridDim.z;
  unsigned sum, cnt, mine, sp = 0u;
  for (;;) {
    sum = 0u; cnt = 0u; mine = 0u;
#pragma unroll
    for (unsigned j = 0; j < 16; ++j) { const unsigned c = xb_ld(&bar[XB_XCNT(j)]); sum += c; cnt += (c > 0u) ? 1u : 0u; mine = (j == x) ? c : mine; }
    if (sum == G) break;
    __builtin_amdgcn_s_sleep(1);
    if ((++sp & 255u) == 0u) { if (xb_ld(&bar[XB_TMO])) break; if (sp > XB_SPIN_CAP) { atomicAdd(&bar[XB_TMO], 1u); break; } }
  }
  nloc = mine > 0u ? mine : 1u; nx = cnt > 0u ? cnt : 1u;
}
__device__ __forceinline__ void xcd_barrier(const XcdBarrier& b) {
  asm volatile("s_waitcnt vmcnt(0)" ::: "memory");
  __syncthreads();
  if (threadIdx.x == 0) {
    unsigned* bar = b.bar;
    __builtin_amdgcn_s_waitcnt(0);
    unsigned nloc = b.st[0], nx = b.st[1];
    if (nloc == 0u) { xcd_barrier_complete(bar, b.x, nloc, nx); b.st[0] = nloc; b.st[1] = nx; }
    const unsigned old = xb_add(&bar[XB_XSUB(b.x)], 1u);
    const unsigned gen = old / nloc;
    if (old + 1u == (gen + 1u) * nloc) {
      __builtin_amdgcn_fence(__ATOMIC_RELEASE, "agent");
      asm volatile("s_waitcnt vmcnt(0)" ::: "memory");
      const unsigned og = xb_add(&bar[XB_TOP], 1u);
      const unsigned tg = og / nx;
      if (og + 1u == (tg + 1u) * nx) xb_add(&bar[XB_TOPGEN], 1u);
      else XB_SPIN(xb_ld(&bar[XB_TOPGEN]) == tg, bar);
      __builtin_amdgcn_fence(__ATOMIC_ACQUIRE, "agent");
      xb_add(&bar[XB_XGEN(b.x)], 1u);
      asm volatile("s_waitcnt vmcnt(0)" ::: "memory");
    } else {
      XB_SPIN(xb_ld(&bar[XB_XGEN(b.x)]) == gen, bar);
      __builtin_amdgcn_fence(__ATOMIC_ACQUIRE, "agent");
      asm volatile("s_waitcnt vmcnt(0)" ::: "memory");
    }
  }
  __syncthreads();
}

__global__ void __launch_bounds__(512, 2) mega(Params p) {
  extern __shared__ __attribute__((aligned(16))) unsigned char lds_raw[];
  Ctx c; c.flds = (LAS unsigned char*)lds_raw; c.l = 0; relaunder(c);
  volatile LAS unsigned* xst = (volatile LAS unsigned*)(c.flds + LDS_XST);
  if (c.ftid < 4) xst[c.ftid] = 0u;
  __syncthreads();
  (void)xcd_barrier_post((unsigned*)get_ka()->ws, xst);
#define XBAR() do { XcdBarrier xb_; xb_.bar = (unsigned*)get_ka()->ws; xb_.x = xb_xcc_id(); xb_.st = (volatile LAS unsigned*)((LAS unsigned char*)lds_raw + LDS_XST); xcd_barrier(xb_); } while (0)

  relaunder(c); for (int it = c.fblk; it < 192; it += c.fnblk) mod_item(c, it);
  relaunder(c); phase_convert_S(c, 0);
  relaunder(c); phase_rope_tables(c);
  XBAR();
  relaunder(c); phase_u0(c);
  XBAR();
  for (int l = 0; l < 2; ++l) {
    const int ntok = (l == 0) ? NT : NL;
    relaunder(c); phase_inproj(c);
    XBAR();
    relaunder(c); phase_mixer_prep(c, l);
    XBAR();
    relaunder(c); phase_mla_up(c, l);
    XBAR();
    relaunder(c); phase_mixers(c, l);
    XBAR();
    relaunder(c); phase_outproj(c, ntok);
    XBAR();
    relaunder(c); phase_postmix(c, l, ntok);
    XBAR();
    relaunder(c); phase_router(c, l, ntok);
    XBAR();
    relaunder(c); phase_positions(c, ntok);
    XBAR();
    relaunder(c); phase_gateup(c, ntok);
    XBAR();
    relaunder(c); phase_down(c, ntok);
    XBAR();
    relaunder(c); phase_combine(c, l, ntok);
    if (l == 0) { relaunder(c); phase_convert_S(c, 1); XBAR(); }
  }
}

extern "C" void kernel_launch(void* const* d_in, const int* in_sizes, int n_in, void* d_out, int out_size,
                              void* d_ws, size_t ws_size, hipStream_t stream) {
  static int grid = 0;
  if (!grid) {
    int dev = 0, cus = 0, per_cu = 0;
    (void)hipGetDevice(&dev);
    (void)hipDeviceGetAttribute(&cus, hipDeviceAttributeMultiprocessorCount, dev);
    (void)hipFuncSetAttribute((const void*)mega, hipFuncAttributeMaxDynamicSharedMemorySize, LDS_BYTES);
    (void)hipOccupancyMaxActiveBlocksPerMultiprocessor(&per_cu, (const void*)mega, 512, LDS_BYTES);
    if (per_cu > 1) per_cu = 1;
    if (per_cu < 1) per_cu = 1;
    grid = cus * per_cu; grid -= grid % 8;
    if (ws_size < WS_NEED) fprintf(stderr, "kernel_launch: workspace too small: %zu < %zu\n", ws_size, (size_t)WS_NEED);
  }
  Params p{};
  for (int i = 0; i < N_IN; ++i) p.in[i] = (const float*)d_in[i];
  p.out = (float*)d_out; p.ws = (unsigned char*)d_ws;
  (void)hipMemsetAsync(d_ws, 0, 16384, stream);
  void* args[] = {&p};
  hipError_t e = hipLaunchCooperativeKernel((const void*)mega, dim3(grid), dim3(512), args, LDS_BYTES, stream);
  if (e != hipSuccess) fprintf(stderr, "coop launch failed: %s\n", hipGetErrorString(e));
}
```

```cpp
#include <hip/hip_runtime.h>
#include <hip/hip_cooperative_groups.h>
#include <cstdio>
#include <cmath>
namespace cg = cooperative_groups;

typedef unsigned short bf16_t;
typedef short bf16x8 __attribute__((ext_vector_type(8)));
typedef short s16x4 __attribute__((ext_vector_type(4)));
typedef float f32x2 __attribute__((ext_vector_type(2)));
typedef float f32x4 __attribute__((ext_vector_type(4)));
typedef float f32x16 __attribute__((ext_vector_type(16)));
typedef unsigned u32x2 __attribute__((ext_vector_type(2)));
typedef unsigned u32x4 __attribute__((ext_vector_type(4)));
typedef __bf16 bf16x2_t __attribute__((ext_vector_type(2)));
#define LAS __attribute__((address_space(3)))

constexpr int D = 1024, NB = 8, SEQ = 2048, CL = 256;
constexpr int NL = NB * SEQ, NC = NB * CL, NT = NL + NC;
constexpr int PLD = 1920;
constexpr int cAQ = 0, cAK = 256, cAV = 384, cBX = 512, cBG = 768, cCQ = 1024, cCK = 1280, cCV = 1408, cDQ = 1536, cDKV = 1728, cDKR = 1856;
constexpr int NE = 64;
constexpr float EPS = 1e-6f;
constexpr float LOG2E = 1.4426950408889634f;
constexpr int LDS_BYTES = 135168, LDS_TAB = 131072, LDS_XST = 132096, LDS_LW = 133120;

enum { I_X = 0, I_C, I_CTX, I_CCTX, I_WMOD, I_BMOD, I_GPREMIX, I_GPOSTMIX, I_GPREFFN, I_GPOSTFFN, I_WIN, I_AQN, I_AKN, I_CONVW, I_CONVB,
       I_LRUWA, I_LRUBA, I_LRUWI, I_LRUBI, I_LRULAM, I_CSINK, I_DQN, I_DWUQ, I_DKVN, I_DWUKV, I_WOUT, I_RW, I_RB, I_WG, I_WU, I_WD, I_SHG, I_SHU, I_SHD, N_IN };

constexpr size_t MiB = 1u << 20;
constexpr size_t OFF_MOD = 1 * MiB;
constexpr size_t OFF_ROPE = 1572864;
constexpr size_t OFF_CX = 3 * MiB;
constexpr size_t OFF_ROUTE = 11 * MiB;
constexpr size_t RT_IDX = OFF_ROUTE, RT_W = RT_IDX + 589824, RT_POSMAP = RT_W + 589824, RT_LTOK = RT_POSMAP + 589824, RT_LW = RT_LTOK + 589824,
                 RT_TCNT = RT_LW + 589824, RT_EOFF = RT_TCNT + 36864, RT_ECNT = RT_EOFF + 512;
constexpr size_t OFF_AGG = 15 * MiB;
constexpr size_t OFF_WT = 17 * MiB;
constexpr size_t WT_WIN = OFF_WT, WT_WOUT = WT_WIN + 4194304, WT_WGU = WT_WOUT + 2097152, WT_WD = WT_WGU + 68157440, WT_WUQ = WT_WD + 34078720,
                 WT_WUKV = WT_WUQ + 147456, WT_RHI = WT_WUKV + 131072, WT_RLO = WT_RHI + 262144, WT_LRU = WT_RLO + 262144;
constexpr size_t OFF_UH = 122 * MiB;
constexpr size_t OFF_BIG = 203 * MiB;
constexpr size_t BG_PROJ = OFF_BIG, BG_QD = BG_PROJ + 70778880, BG_KD = BG_QD + 14155776, BG_VD = BG_KD + 14155776, BG_DQN = BG_VD + 9437184,
                 BG_DKVN = BG_DQN + 7077888, BG_HL = BG_DKVN + 4718592, BG_PL = BG_HL + 18874368, BG_YMIX = BG_PL + 18874368,
                 BG_YOUT = BG_YMIX + 37748736, BG_VHI = BG_YOUT + 37748736, BG_VLO = BG_VHI + 37748736;
constexpr size_t BG_Y = OFF_BIG;
constexpr size_t BG_YS = OFF_BIG + 176 * MiB;
constexpr size_t WS_NEED = OFF_BIG + 339738624;

struct Params {
  const float* in[N_IN];
  float* out;
  unsigned char* ws;
};

__device__ __forceinline__ float bf2f(bf16_t h) { return __uint_as_float(((unsigned)h) << 16); }
__device__ __forceinline__ unsigned pk2(float lo, float hi) { f32x2 v = {lo, hi}; bf16x2_t b = __builtin_convertvector(v, bf16x2_t); return __builtin_bit_cast(unsigned, b); }
__device__ __forceinline__ bf16_t f2bf(float f) { return (bf16_t)(pk2(f, 0.f) & 0xffffu); }
template <int X> __device__ __forceinline__ float swz_xor(float v) { return __builtin_bit_cast(float, __builtin_amdgcn_ds_swizzle(__builtin_bit_cast(int, v), (X << 10) | 0x1F)); }
__device__ __forceinline__ float bperm(float v, int srclane) { return __builtin_bit_cast(float, __builtin_amdgcn_ds_bpermute(srclane << 2, __builtin_bit_cast(int, v))); }
__device__ __forceinline__ float xhalf_sum(float v) { const auto r = __builtin_amdgcn_permlane32_swap(__builtin_bit_cast(unsigned, v), __builtin_bit_cast(unsigned, v), false, false); return __builtin_bit_cast(float, (unsigned)r[0]) + __builtin_bit_cast(float, (unsigned)r[1]); }
__device__ __forceinline__ float xhalf_max(float v) { const auto r = __builtin_amdgcn_permlane32_swap(__builtin_bit_cast(unsigned, v), __builtin_bit_cast(unsigned, v), false, false); return fmaxf(__builtin_bit_cast(float, (unsigned)r[0]), __builtin_bit_cast(float, (unsigned)r[1])); }
__device__ __forceinline__ float wave_sum(float v) {
  v += swz_xor<1>(v); v += swz_xor<2>(v); v += swz_xor<4>(v); v += swz_xor<8>(v); v += swz_xor<16>(v);
  return xhalf_sum(v);
}
__device__ __forceinline__ float sigmoidf_(float x) { return __builtin_amdgcn_rcpf(1.0f + __expf(-x)); }
__device__ __forceinline__ float gelu_tanh(float x) { const float u = 0.7978845608028654f * (x + 0.044715f * x * x * x); return x * (1.0f - __builtin_amdgcn_rcpf(1.0f + __expf(2.0f * u)));   }
__device__ __forceinline__ int crow(int r, int hi) { return (r & 3) + 8 * (r >> 2) + 4 * hi; }
__device__ __forceinline__ void unpack4(u32x2 w, float& a, float& b, float& c, float& d) {
  a = __uint_as_float(w.x << 16); b = __uint_as_float(w.x & 0xffff0000u); c = __uint_as_float(w.y << 16); d = __uint_as_float(w.y & 0xffff0000u);
}

__device__ __forceinline__ void store_pair_bf16(bf16_t* rp, int fq, u32x2 a, u32x2 b, bool ok) {
  const auto rx = __builtin_amdgcn_permlane16_swap(a.x, b.x, false, false);
  const auto ry = __builtin_amdgcn_permlane16_swap(a.y, b.y, false, false);
  const int col = (fq & 1) ? 16 + 4 * (fq - 1) : 4 * fq;
  if (ok) *(u32x4*)(rp + col) = (u32x4){rx[0], ry[0], rx[1], ry[1]};
}
typedef const __attribute__((address_space(4))) Params* KP;
__device__ __forceinline__ void relaunder(struct Ctx& c);
__device__ __forceinline__ KP get_ka() { KP k = (KP)__builtin_amdgcn_kernarg_segment_ptr(); asm volatile("" : "+s"(k)); return k; }
struct Ctx {
  KP p; int l; int tid, lane, wid; LAS unsigned char* lds; int nblk, blk;
  int ftid, fwid, fnblk, fblk, hb, wid0; LAS unsigned char* flds;
};

__device__ __forceinline__ void relaunder(Ctx& c) {
  c.p = get_ka();
  int w = c.wid0; asm volatile("" : "+s"(w));
  unsigned z0; asm volatile("v_mov_b32 %0, 0" : "=v"(z0));
  int ln = (int)__builtin_amdgcn_mbcnt_hi(~0u, __builtin_amdgcn_mbcnt_lo(~0u, z0));
  const int t = w * 64 + ln;
  c.ftid = t; c.lane = ln; c.fwid = w;
  c.hb = c.fwid >> 2; c.tid = t & 255; c.wid = c.fwid & 3;
  int b = blockIdx.x; asm volatile("" : "+s"(b)); c.fblk = b; c.blk = 2 * b + c.hb;
  int n = gridDim.x; asm volatile("" : "+s"(n)); c.fnblk = n; c.nblk = 2 * n;
  c.lds = c.flds + c.hb * 65536;
}
__device__ __forceinline__ int stage_row(int tid, int i) { return i * 32 + (tid >> 3); }
__device__ __forceinline__ int stage_coff(int tid) { return (((tid & 7) ^ ((tid >> 3) & 7)) << 3); }

__device__ __forceinline__ void gemm_core(const Ctx& c, const bf16_t* const (&ap)[4], const bf16_t* const (&bp)[4], int nkseg, int nseg,
                                          long a0, long a1, long a2, long b0, long b1, long b2, f32x4 (&acc)[4][4]) {
  const int lane = c.lane, wid = c.wid, fr = lane & 15, fq = lane >> 4, wr = wid >> 1, wc = wid & 1;
  LAS unsigned char* lds = c.lds;
#pragma unroll
  for (int m = 0; m < 4; ++m)
#pragma unroll
    for (int n = 0; n < 4; ++n) acc[m][n] = (f32x4){0.f, 0.f, 0.f, 0.f};
  const int nk = nkseg * nseg;
#define GEMM_ISSUE(KT) do { const int kt_ = (KT); const int seg_ = kt_ / nkseg, kk_ = kt_ - seg_ * nkseg; \
    const long ao_ = (seg_ == 0 ? a0 : (seg_ == 1 ? a1 : a2)) + (long)kk_ * 64; \
    const long bo_ = (seg_ == 0 ? b0 : (seg_ == 1 ? b1 : b2)) + (long)kk_ * 64; \
    LAS unsigned char* dst_ = lds + (kt_ & 1) * 32768 + wid * 1024; \
    _Pragma("unroll") for (int i_ = 0; i_ < 4; ++i_) __builtin_amdgcn_global_load_lds((const unsigned*)(ap[i_] + ao_), (LAS unsigned*)(dst_ + i_ * 4096), 16, 0, 0); \
    _Pragma("unroll") for (int i_ = 0; i_ < 4; ++i_) __builtin_amdgcn_global_load_lds((const unsigned*)(bp[i_] + bo_), (LAS unsigned*)(dst_ + 16384 + i_ * 4096), 16, 0, 0); } while (0)
  GEMM_ISSUE(0);
  const int aoff = (wr * 64 + fr) * 128, boff = 16384 + (wc * 64 + fr) * 128, sw = fr & 7;
  for (int kt = 0; kt < nk; ++kt) {
    asm volatile("s_waitcnt vmcnt(0)" ::: "memory");
    __syncthreads();
    if (kt + 1 < nk) GEMM_ISSUE(kt + 1);
    LAS unsigned char* base = lds + (kt & 1) * 32768;
    bf16x8 af[4][2], bfr[4][2];
#pragma unroll
    for (int m = 0; m < 4; ++m)
#pragma unroll
      for (int k = 0; k < 2; ++k) af[m][k] = *(LAS bf16x8*)(base + aoff + m * 2048 + (((k * 4 + fq) ^ sw) << 4));
#pragma unroll
    for (int n = 0; n < 4; ++n)
#pragma unroll
      for (int k = 0; k < 2; ++k) bfr[n][k] = *(LAS bf16x8*)(base + boff + n * 2048 + (((k * 4 + fq) ^ sw) << 4));
#pragma unroll
    for (int k = 0; k < 2; ++k)
#pragma unroll
      for (int m = 0; m < 4; ++m)
#pragma unroll
        for (int n = 0; n < 4; ++n) acc[m][n] = __builtin_amdgcn_mfma_f32_16x16x32_bf16(bfr[n][k], af[m][k], acc[m][n], 0, 0, 0);
  }
  __syncthreads();
}

struct ItemInfo { int a, b, c, d; };
template <class F>
__device__ __forceinline__ void gemm_persistent(const Ctx& c, int nitems, int nk, F& f) {
  const int lane = c.lane, wid = c.wid, fr = lane & 15, fq = lane >> 4, wr = wid >> 1, wc = wid & 1;
  LAS unsigned char* lds = c.lds;
  int cur = c.blk;
  if (cur >= nitems) return;
  const bf16_t *ap[4], *bp[4];
  f.pre(cur);
  ItemInfo ci = f.setup(cur, ap, bp);
  unsigned gs = 0;
#define PG_ISSUE(KT, BUFI) do { const long ko_ = (long)(KT) * 64; LAS unsigned char* dst_ = lds + (BUFI) * 32768 + wid * 1024; \
    _Pragma("unroll") for (int i_ = 0; i_ < 4; ++i_) __builtin_amdgcn_global_load_lds((const unsigned*)(ap[i_] + ko_), (LAS unsigned*)(dst_ + i_ * 4096), 16, 0, 0); \
    _Pragma("unroll") for (int i_ = 0; i_ < 4; ++i_) __builtin_amdgcn_global_load_lds((const unsigned*)(bp[i_] + ko_), (LAS unsigned*)(dst_ + 16384 + i_ * 4096), 16, 0, 0); } while (0)
  PG_ISSUE(0, 0);
  const int aoff = (wr * 64 + fr) * 128, boff = 16384 + (wc * 64 + fr) * 128, sw = fr & 7;
  for (;;) {
    f32x4 acc[4][4];
#pragma unroll
    for (int m = 0; m < 4; ++m)
#pragma unroll
      for (int n = 0; n < 4; ++n) acc[m][n] = (f32x4){0.f, 0.f, 0.f, 0.f};
    const int nxt = cur + c.nblk; const bool has_next = nxt < nitems;
    ItemInfo ni = ci;
    for (int kt = 0; kt < nk; ++kt) {
      asm volatile("s_waitcnt vmcnt(0)" ::: "memory");
      __syncthreads();
      if (kt + 1 < nk) { PG_ISSUE(kt + 1, (gs + 1) & 1); if (kt == nk - 2 && has_next) f.pre(nxt); }
      else if (has_next) { ni = f.setup(nxt, ap, bp); PG_ISSUE(0, (gs + 1) & 1); }
      LAS unsigned char* base = lds + (gs & 1) * 32768;
      bf16x8 af[4][2], bfr[4][2];
#pragma unroll
      for (int m = 0; m < 4; ++m)
#pragma unroll
        for (int k = 0; k < 2; ++k) af[m][k] = *(LAS bf16x8*)(base + aoff + m * 2048 + (((k * 4 + fq) ^ sw) << 4));
#pragma unroll
      for (int n = 0; n < 4; ++n)
#pragma unroll
        for (int k = 0; k < 2; ++k) bfr[n][k] = *(LAS bf16x8*)(base + boff + n * 2048 + (((k * 4 + fq) ^ sw) << 4));
#pragma unroll
      for (int k = 0; k < 2; ++k)
#pragma unroll
        for (int m = 0; m < 4; ++m)
#pragma unroll
          for (int n = 0; n < 4; ++n) acc[m][n] = __builtin_amdgcn_mfma_f32_16x16x32_bf16(bfr[n][k], af[m][k], acc[m][n], 0, 0, 0);
      ++gs;
    }
    f.epi(ci, acc);
    if (!has_next) break;
    cur = nxt; ci = ni;
  }
  __syncthreads();
#undef PG_ISSUE
}

__device__ __forceinline__ int stage_row8(int ftid, int i) { return i * 64 + (ftid >> 3); }
template <int NW, class F>
__device__ __forceinline__ void gemm8_persistent(const Ctx& c, int first, int stride, int nitems, int nk, F& f) {
  const int lane = c.lane, wid = c.fwid, fr = lane & 15, fq = lane >> 4, wr = wid >> 1, wc = wid & 1;
  LAS unsigned char* lds = c.flds;
  int cur = first;
  if (cur >= nitems) return;
  unsigned ap[4], bp[4];
  f.pre(cur);
  ItemInfo ci = f.setup(cur, ap, bp);
  unsigned gs = 0;
#define PG8_ISSUE(KT, BUFI) do { const long ko_ = (long)(KT) * 64; LAS unsigned char* dst_ = lds + (BUFI) * 65536 + wid * 1024; \
    _Pragma("unroll") for (int i_ = 0; i_ < 4; ++i_) __builtin_amdgcn_global_load_lds((const unsigned*)(f.Abase() + ap[i_] + ko_), (LAS unsigned*)(dst_ + i_ * 8192), 16, 0, 0); \
    _Pragma("unroll") for (int i_ = 0; i_ < NW / 2; ++i_) __builtin_amdgcn_global_load_lds((const unsigned*)(f.Bbase() + bp[i_] + ko_), (LAS unsigned*)(dst_ + 32768 + i_ * 8192), 16, 0, 0); } while (0)
  PG8_ISSUE(0, 0);
  const int aoff = (wr * 64 + fr) * 128, boff = 32768 + (wc * (NW * 16) + fr) * 128, sw = fr & 7;
  for (;;) {
    f32x4 acc[4][NW];
#pragma unroll
    for (int m = 0; m < 4; ++m)
#pragma unroll
      for (int n = 0; n < NW; ++n) acc[m][n] = (f32x4){0.f, 0.f, 0.f, 0.f};
    const int nxt = cur + stride; const bool has_next = nxt < nitems;
    ItemInfo ni = ci;
#pragma unroll 1
    for (int kt = 0; kt < nk; ++kt) {
      asm volatile("s_waitcnt vmcnt(0)" ::: "memory");
      __syncthreads();
      if (kt + 1 >= nk && has_next) ni = f.setup(nxt, ap, bp);
      LAS unsigned char* base = lds + (gs & 1) * 65536;
#pragma unroll
      for (int k = 0; k < 2; ++k) {
        bf16x8 af[4], bfr[NW];
#pragma unroll
        for (int m = 0; m < 4; ++m) af[m] = *(LAS bf16x8*)(base + aoff + m * 2048 + (((k * 4 + fq) ^ sw) << 4));
#pragma unroll
        for (int n = 0; n < NW; ++n) bfr[n] = *(LAS bf16x8*)(base + boff + n * 2048 + (((k * 4 + fq) ^ sw) << 4));
        if (k == 0) {
          if (kt + 1 < nk) { PG8_ISSUE(kt + 1, (gs + 1) & 1); if (kt == nk - 2 && has_next) f.pre(nxt); }
          else if (has_next) { PG8_ISSUE(0, (gs + 1) & 1); }
        }
#pragma unroll
        for (int m = 0; m < 4; ++m)
#pragma unroll
          for (int n = 0; n < NW; ++n) acc[m][n] = __builtin_amdgcn_mfma_f32_16x16x32_bf16(bfr[n], af[m], acc[m][n], 0, 0, 0);
        if (k == 0 && NW == 8) {
#pragma unroll
          for (int q = 0; q < 8; ++q) { __builtin_amdgcn_sched_group_barrier(0x008, 3, 0); __builtin_amdgcn_sched_group_barrier(0x010, 1, 0); }
        }
      }
      ++gs;
    }
    f.epi(ci, acc);
    if (!has_next) break;
    cur = nxt; ci = ni;
  }
  __syncthreads();
#undef PG8_ISSUE
}

namespace p8 {
constexpr int HTB = 16384;
__device__ __forceinline__ int lds_byte(int r, int c) { const int st = (r >> 4) * 2 + (c >> 5), rr = r & 15, cc = c & 31, ob = rr * 64 + cc * 2; return st * 1024 + (ob ^ (((ob >> 9) & 1) << 5)); }
__device__ __forceinline__ void stage_rc(int b, int& R, int& C) { const int st = b / 1024, sb = b % 1024, swz = sb ^ (((sb >> 9) & 1) << 5); R = (st >> 1) * 16 + swz / 64; C = (st & 1) * 32 + (swz % 64) / 2; }
__device__ __forceinline__ int perm32(int rho) { const int n = rho >> 4, i = rho & 15; return 8 * (i >> 2) + 4 * n + (i & 3); }
struct Unit { int pm, pn, e, cnt, row0; };
template <class F>
__device__ __forceinline__ void gemm(const Ctx& c, F& f) {
  LAS unsigned char* lds = c.flds;
  const int tid = c.ftid, wid = c.fwid, lane = c.lane, wr = wid >> 2, wc = wid & 3, fr = lane & 15, fq = lane >> 4;
  const int K = f.K, nt = K / 64;
  int Rr[2], Cc[2]; unsigned voffB[2];
#pragma unroll
  for (int i = 0; i < 2; ++i) { stage_rc(tid * 16 + i * 8192, Rr[i], Cc[i]); const int Rb = F::permB(Rr[i]); voffB[i] = (unsigned)(Rb * K + Cc[i]) * 2u; }
  const size_t kstep = 128, hstep = (size_t)F::BH_ROWS * K * 2;
  const unsigned ldsw = (unsigned)wid * 1024u;
  const int aoff = lds_byte(wr * 64 + fr, fq * 8), boff = lds_byte(wc * 32 + fr, fq * 8);
#define P8_SA(b, h) (((b) * 2 + (h)) * p8::HTB)
#define P8_SB(b, h) ((4 + (b) * 2 + (h)) * p8::HTB)
#define P8_STAGE(bufoff, gbase, voff) do { _Pragma("unroll") for (int _i = 0; _i < 2; ++_i) \
    __builtin_amdgcn_global_load_lds((const unsigned*)((const char*)(gbase) + (voff)[_i]), (LAS unsigned*)(lds + (bufoff) + ldsw + _i * 8192), 16, 0, 0); } while (0)
#define P8_LDA(dst, b, h) do { _Pragma("unroll") for (int m = 0; m < 4; ++m) _Pragma("unroll") for (int k = 0; k < 2; ++k) dst[m][k] = *(const LAS bf16x8*)(lds + P8_SA(b, h) + aoff + m * 2048 + k * 1024); } while (0)
#define P8_LDB(dst, b, h) do { _Pragma("unroll") for (int n = 0; n < 2; ++n) _Pragma("unroll") for (int k = 0; k < 2; ++k) dst[n][k] = *(const LAS bf16x8*)(lds + P8_SB(b, h) + boff + n * 2048 + k * 1024); } while (0)
#define P8_MMA(ai, bj, At, Bt) do { __builtin_amdgcn_s_setprio(1); _Pragma("unroll") for (int m = 0; m < 4; ++m) _Pragma("unroll") for (int n = 0; n < 2; ++n) _Pragma("unroll") for (int k = 0; k < 2; ++k) \
    acc[ai][bj][m][n] = __builtin_amdgcn_mfma_f32_16x16x32_bf16(Bt[n][k], At[m][k], acc[ai][bj][m][n], 0, 0, 0); __builtin_amdgcn_s_setprio(0); } while (0)
#define P8_WAIT_V(n) asm volatile("s_waitcnt vmcnt(" #n ")" ::: "memory")
#define P8_WAIT_L(n) asm volatile("s_waitcnt lgkmcnt(" #n ")" ::: "memory")
#define P8_BAR __builtin_amdgcn_s_barrier()
#define P8_SCHED __builtin_amdgcn_sched_barrier(0)
  Unit cur, nxt; int ui = 0;
  if (!f.next(0, cur)) return;
  f32x4 acc[2][2][4][2];
#pragma unroll
  for (int a = 0; a < 2; ++a)
#pragma unroll
    for (int b = 0; b < 2; ++b)
#pragma unroll
      for (int m = 0; m < 4; ++m)
#pragma unroll
        for (int n = 0; n < 2; ++n) acc[a][b][m][n] = (f32x4){0.f, 0.f, 0.f, 0.f};
  bf16x8 At[4][2], B0[2][2], B1[2][2];
  unsigned vA0[2], vA1[2], vN0[2], vN1[2];
  f.a_offs(cur, Rr, Cc, vA0, vA1);
  const char* cA = f.a_base(cur); const char* cB = f.b_base(cur);
  P8_STAGE(P8_SB(0, 0), cB, voffB); P8_STAGE(P8_SB(0, 1), cB + hstep, voffB); P8_STAGE(P8_SA(0, 0), cA, vA0); P8_STAGE(P8_SA(0, 1), cA, vA1);
  if (wr == 1) P8_BAR;
  P8_WAIT_V(2); P8_BAR;
  P8_STAGE(P8_SB(1, 0), cB + kstep, voffB); P8_STAGE(P8_SA(1, 0), cA + kstep, vA0); P8_STAGE(P8_SB(1, 1), cB + hstep + kstep, voffB);
  P8_WAIT_V(6); P8_BAR;
  for (;;) {
    const bool nob1 = F::HALF_N && f.skip_b1(cur);
    f.unit_begin(cur, ui, lds, wid, lane);
    const bool has_next = f.next(ui + 1, nxt);
    const char* nA = has_next ? f.a_base(nxt) : cA; const char* nB = has_next ? f.b_base(nxt) : cB;
    if (has_next) f.a_offs(nxt, Rr, Cc, vN0, vN1); else { vN0[0] = vA0[0]; vN0[1] = vA0[1]; vN1[0] = vA1[0]; vN1[1] = vA1[1]; }
#pragma unroll 1
    for (int t = 0; t < nt; t += 2) {
      const bool last = (t == nt - 2);
      const char* a1 = cA + (size_t)(t + 1) * kstep;
      const char* a2 = last ? nA : cA + (size_t)(t + 2) * kstep; const char* b2 = last ? nB : cB + (size_t)(t + 2) * kstep;
      const char* a3 = a2 + kstep; const char* b3 = b2 + kstep;
      unsigned w0[2], w1[2];
      w0[0] = last ? vN0[0] : vA0[0]; w0[1] = last ? vN0[1] : vA0[1]; w1[0] = last ? vN1[0] : vA1[0]; w1[1] = last ? vN1[1] : vA1[1];
      P8_LDB(B0, 0, 0); P8_LDB(B1, 0, 1); P8_SCHED; P8_LDA(At, 0, 0); P8_STAGE(P8_SA(1, 1), a1, vA1);
      P8_WAIT_V(8); P8_WAIT_L(0); P8_BAR; P8_MMA(0, 0, At, B0); if (!nob1) P8_MMA(0, 1, At, B1); P8_BAR; P8_SCHED;
      P8_LDA(At, 0, 1); P8_STAGE(P8_SB(0, 0), b2, voffB); P8_STAGE(P8_SB(0, 1), b2 + hstep, voffB); P8_STAGE(P8_SA(0, 0), a2, w0);
      P8_WAIT_V(8); P8_WAIT_L(0); P8_BAR; P8_MMA(1, 0, At, B0); if (!nob1) P8_MMA(1, 1, At, B1); P8_BAR; P8_SCHED;
      P8_LDB(B0, 1, 0); P8_LDB(B1, 1, 1); P8_SCHED; P8_LDA(At, 1, 0); P8_STAGE(P8_SA(0, 1), a2, w1);
      P8_WAIT_V(8); P8_WAIT_L(0); P8_BAR; P8_MMA(0, 0, At, B0); if (!nob1) P8_MMA(0, 1, At, B1); P8_BAR; P8_SCHED;
      P8_LDA(At, 1, 1); P8_STAGE(P8_SB(1, 0), b3, voffB); P8_STAGE(P8_SB(1, 1), b3 + hstep, voffB); P8_STAGE(P8_SA(1, 0), a3, w0);
      P8_WAIT_V(8); P8_WAIT_L(0); P8_BAR; P8_MMA(1, 0, At, B0); if (!nob1) P8_MMA(1, 1, At, B1); P8_BAR; P8_SCHED;
    }
    if (wr == 0) P8_BAR;
    f.epi(acc, cur, wr, wc, fr, fq, ui, lds);
    if (!has_next) break;
#pragma unroll
    for (int a = 0; a < 2; ++a)
#pragma unroll
      for (int b = 0; b < 2; ++b)
#pragma unroll
        for (int m = 0; m < 4; ++m)
#pragma unroll
          for (int n = 0; n < 2; ++n) acc[a][b][m][n] = (f32x4){0.f, 0.f, 0.f, 0.f};
    cur = nxt; cA = nA; cB = nB; vA0[0] = vN0[0]; vA0[1] = vN0[1]; vA1[0] = vN1[0]; vA1[1] = vN1[1]; ++ui;
    if (wr == 1) P8_BAR;
  }
  P8_WAIT_V(0);
  P8_BAR;
#undef P8_SA
#undef P8_SB
#undef P8_STAGE
#undef P8_LDA
#undef P8_LDB
#undef P8_MMA
#undef P8_WAIT_V
#undef P8_WAIT_L
#undef P8_BAR
#undef P8_SCHED
}
}

__device__ __forceinline__ void rows_plain(const Ctx& c, const bf16_t* base, long ld, int row0, const bf16_t* (&rp)[4]) {
  const int co = stage_coff(c.tid);
#pragma unroll
  for (int i = 0; i < 4; ++i) rp[i] = base + (long)(row0 + stage_row(c.tid, i)) * ld + co;
}

__device__ __forceinline__ void store_tile_bf16(const Ctx& c, const f32x4 (&acc)[4][4], bf16_t* base, long ld, int row0, int col0, int rows_valid) {
  const int lane = c.lane, wid = c.wid, fr = lane & 15, fq = lane >> 4, wr = wid >> 1, wc = wid & 1;
#pragma unroll
  for (int m = 0; m < 4; ++m) {
    const int rl = wr * 64 + m * 16 + fr;
    if (rl < rows_valid) {
      bf16_t* rp = base + (long)(row0 + rl) * ld + col0 + wc * 64 + 4 * fq;
#pragma unroll
      for (int n = 0; n < 4; ++n) { u32x2 w; w.x = pk2(acc[m][n][0], acc[m][n][1]); w.y = pk2(acc[m][n][2], acc[m][n][3]); *(u32x2*)(rp + n * 16) = w; }
    }
  }
}

__device__ __forceinline__ void tconv_load(const Ctx& c, const float* src, int ldn, int ncols, int k0, int n0, f32x4 (&va)[16]) {
  const int tid = c.tid, c4 = tid & 63, kg = tid >> 6;
  const bool colok = (n0 + 4 * c4) < ncols;
  const float* sp = src + (long)(k0 + kg * 16) * ldn + n0 + 4 * c4;
#pragma unroll
  for (int r = 0; r < 16; ++r) va[r] = colok ? *(const f32x4*)(sp + (long)r * ldn) : (f32x4){0.f, 0.f, 0.f, 0.f};
}
__device__ __forceinline__ void tconv_finish(const Ctx& c, const f32x4 (&va)[16], int k0, int n0, bf16_t* dst, bf16_t* dst2, int ldk, int mode, int nrows_dst) {
  LAS unsigned char* T = c.lds;
  LAS unsigned char* T2 = c.lds + 34816;
  const int tid = c.tid, c4 = tid & 63, kg = tid >> 6;
  asm volatile("s_waitcnt lgkmcnt(0)" ::: "memory"); __builtin_amdgcn_s_barrier(); asm volatile("" ::: "memory");
#pragma unroll
  for (int kq = 0; kq < 4; ++kq) {
    f32x4 v[4];
#pragma unroll
    for (int r = 0; r < 4; ++r) v[r] = va[kq * 4 + r];
#pragma unroll
    for (int e = 0; e < 4; ++e) {
      u32x2 w; w.x = pk2(v[0][e], v[1][e]); w.y = pk2(v[2][e], v[3][e]);
      *(LAS u32x2*)(T + (4 * c4 + e) * 136 + (kg * 16 + kq * 4) * 2) = w;
      if (mode == 3 && c4 < 16) {
        float a0, a1, a2, a3; { u32x2 t = w; unpack4(t, a0, a1, a2, a3); }
        u32x2 w2; w2.x = pk2(v[0][e] - a0, v[1][e] - a1); w2.y = pk2(v[2][e] - a2, v[3][e] - a3);
        *(LAS u32x2*)(T2 + (4 * c4 + e) * 136 + (kg * 16 + kq * 4) * 2) = w2;
      }
    }
  }
  asm volatile("s_waitcnt lgkmcnt(0)" ::: "memory"); __builtin_amdgcn_s_barrier(); asm volatile("" ::: "memory");
#pragma unroll
  for (int j = 0; j < 8; ++j) {
    const int id = j * 256 + tid, n = id >> 3, kc = id & 7;
    const int ng = n0 + n;
    int drow = ng;
    if (mode == 1) drow = 256 * (ng >> 7) + (ng & 127);
    else if (mode == 2) drow = 256 * (ng >> 7) + 128 + (ng & 127);
    if (drow < nrows_dst) {
      const u32x2 a = *(LAS u32x2*)(T + n * 136 + kc * 16), b = *(LAS u32x2*)(T + n * 136 + kc * 16 + 8);
      *(u32x4*)(dst + (long)drow * ldk + k0 + kc * 8) = (u32x4){a.x, a.y, b.x, b.y};
      if (mode == 3) {
        u32x4 o2 = {0u, 0u, 0u, 0u};
        if (n < 64) { const u32x2 a2 = *(LAS u32x2*)(T2 + n * 136 + kc * 16), b2 = *(LAS u32x2*)(T2 + n * 136 + kc * 16 + 8); o2 = (u32x4){a2.x, a2.y, b2.x, b2.y}; }
        *(u32x4*)(dst2 + (long)drow * ldk + k0 + kc * 8) = o2;
      }
    }
  }
}
__device__ __forceinline__ void tconv256(const Ctx& c, const float* src, int ldn, int ncols, int k0, int n0, bf16_t* dst, bf16_t* dst2, int ldk, int mode, int nrows_dst) {
  f32x4 va[16];
  tconv_load(c, src, ldn, ncols, k0, n0, va);
  tconv_finish(c, va, k0, n0, dst, dst2, ldk, mode, nrows_dst);
}

constexpr int CVS_WIN = 128, CVS_UQ = 6, CVS_UKV = 4, CVS_RT = 16, CVS_LRU = 16, CVS_TOTAL = CVS_WIN + CVS_UQ + CVS_UKV + CVS_RT + CVS_LRU;
constexpr int CVO_TOTAL = 64;
constexpr int CVE_EXP = 1024, CVE_SH = 16, CVE_TOTAL = 3 * CVE_EXP + 3 * CVE_SH;
__device__ __forceinline__ void conv_item_S(const Ctx& c, int l, int it) {
  const KP p = c.p; unsigned char* ws = p->ws;
  if (it < CVS_WIN) { const int kt = it >> 3, nt = it & 7; tconv256(c, p->in[I_WIN] + (long)l * 1024 * 1888, 1888, 1888, kt * 64, nt * 256, (bf16_t*)(ws + WT_WIN), nullptr, 1024, 0, 2048); return; }
  it -= CVS_WIN;
  if (it < CVS_UQ) { const int kt = it >> 1, nt = it & 1; tconv256(c, p->in[I_DWUQ] + (long)l * 192 * 384, 384, 384, kt * 64, nt * 256, (bf16_t*)(ws + WT_WUQ), nullptr, 192, 0, 384); return; }
  it -= CVS_UQ;
  if (it < CVS_UKV) { const int kt = it >> 1, nt = it & 1; tconv256(c, p->in[I_DWUKV] + (long)l * 128 * 512, 512, 512, kt * 64, nt * 256, (bf16_t*)(ws + WT_WUKV), nullptr, 128, 0, 512); return; }
  it -= CVS_UKV;
  if (it < CVS_RT) { tconv256(c, p->in[I_RW] + (long)l * 1024 * 64, 64, 64, it * 64, 0, (bf16_t*)(ws + WT_RHI), (bf16_t*)(ws + WT_RHI) + 64 * 1024, 1024, 3, 64); return; }
  it -= CVS_RT;
  { const int gate = it / 8, r = it % 8, d = r / 4, h = r % 4;
    tconv256(c, p->in[gate ? I_LRUWI : I_LRUWA] + ((long)((l * 2 + d) * 4 + h)) * 4096, 64, 64, 0, 0, (bf16_t*)(ws + WT_LRU) + ((long)((d * 2 + gate) * 4 + h)) * 4096, nullptr, 64, 0, 64); }
}
__device__ __forceinline__ void conv_item_O(const Ctx& c, int l, int it) {
  const int kt = it >> 2, nt = it & 3;
  tconv256(c, c.p->in[I_WOUT] + (long)l * 1024 * 1024, 1024, 1024, kt * 64, nt * 256, (bf16_t*)(c.p->ws + WT_WOUT), nullptr, 1024, 0, 1024);
}
__device__ __forceinline__ void conv_item_E(const Ctx& c, int l, int it) {
  const KP p = c.p; unsigned char* ws = p->ws;
  if (it < 2 * CVE_EXP) {
    const int up = it / CVE_EXP, r = it % CVE_EXP, e = r >> 4, kt = r & 15;
    tconv256(c, p->in[up ? I_WU : I_WG] + ((long)(l * 64 + e)) * 1024 * 256, 256, 256, kt * 64, 0, (bf16_t*)(ws + WT_WGU) + (long)e * 512 * 1024, nullptr, 1024, 1 + up, 512); return;
  }
  it -= 2 * CVE_EXP;
  if (it < CVE_EXP) {
    const int e = it >> 4, t = it & 15, kt = t >> 2, nt = t & 3;
    tconv256(c, p->in[I_WD] + ((long)(l * 64 + e)) * 256 * 1024, 1024, 1024, kt * 64, nt * 256, (bf16_t*)(ws + WT_WD) + (long)e * 1024 * 256, nullptr, 256, 0, 1024); return;
  }
  it -= CVE_EXP;
  if (it < 2 * CVE_SH) { const int up = it / CVE_SH, kt = it % CVE_SH;
    tconv256(c, p->in[up ? I_SHU : I_SHG] + (long)l * 1024 * 256, 256, 256, kt * 64, 0, (bf16_t*)(ws + WT_WGU) + (long)64 * 512 * 1024, nullptr, 1024, 1 + up, 512); return; }
  it -= 2 * CVE_SH;
  { const int kt = it >> 2, nt = it & 3;
    tconv256(c, p->in[I_SHD] + (long)l * 256 * 1024, 1024, 1024, kt * 64, nt * 256, (bf16_t*)(ws + WT_WD) + (long)64 * 1024 * 256, nullptr, 256, 0, 1024); }
}
__device__ __forceinline__ void phase_convert_S(const Ctx& c, int l) { for (int it = c.blk; it < CVS_TOTAL; it += c.nblk) conv_item_S(c, l, it); }
constexpr int CVE_GU = 2 * CVE_EXP + 2 * CVE_SH, CVE_DN = CVE_EXP + CVE_SH;
constexpr int GU_DED = 2;
__device__ __forceinline__ bool ded_ok(const Ctx& c) { return c.fnblk == 256; }
__device__ __forceinline__ int cve_gu_item(int r) { return r < 2 * CVE_EXP ? r : CVE_EXP + r; }
__device__ __forceinline__ int cve_dn_item(int r) { return r < CVE_EXP ? 2 * CVE_EXP + r : 2 * CVE_EXP + 2 * CVE_SH + r; }
__device__ __forceinline__ void tconvB_load(const Ctx& c, const float* src, int ldn, int k0, int n0, f32x4 (&va)[16]) {
  const int tid = c.tid, c4 = tid & 31, kg = tid >> 5;
  const float* sp = src + (long)(k0 + kg * 16) * ldn + n0 + 4 * c4;
#pragma unroll
  for (int r = 0; r < 16; ++r) va[r] = *(const f32x4*)(sp + (long)r * ldn);
}
__device__ __forceinline__ void tconvB_finish(const Ctx& c, const f32x4 (&va)[16], int k0, int n0, bf16_t* dst, int ldk, int mode, int nrows_dst) {
  LAS unsigned char* T = c.lds;
  const int tid = c.tid, c4 = tid & 31, kg = tid >> 5;
  asm volatile("s_waitcnt lgkmcnt(0)" ::: "memory"); __builtin_amdgcn_s_barrier(); asm volatile("" ::: "memory");
#pragma unroll
  for (int kq = 0; kq < 4; ++kq) {
#pragma unroll
    for (int e = 0; e < 4; ++e) {
      u32x2 w; w.x = pk2(va[kq * 4][e], va[kq * 4 + 1][e]); w.y = pk2(va[kq * 4 + 2][e], va[kq * 4 + 3][e]);
      *(LAS u32x2*)(T + (4 * c4 + e) * 264 + (kg * 16 + kq * 4) * 2) = w;
    }
  }
  asm volatile("s_waitcnt lgkmcnt(0)" ::: "memory"); __builtin_amdgcn_s_barrier(); asm volatile("" ::: "memory");
#pragma unroll
  for (int j = 0; j < 8; ++j) {
    const int id = j * 256 + tid, n = id >> 4, kc = id & 15;
    const int ng = n0 + n;
    int drow = ng;
    if (mode == 1) drow = 256 * (ng >> 7) + (ng & 127);
    else if (mode == 2) drow = 256 * (ng >> 7) + 128 + (ng & 127);
    if (drow < nrows_dst) {
      const u32x2 a = *(LAS u32x2*)(T + n * 264 + kc * 16), b = *(LAS u32x2*)(T + n * 264 + kc * 16 + 8);
      *(u32x4*)(dst + (long)drow * ldk + k0 + kc * 8) = (u32x4){a.x, a.y, b.x, b.y};
    }
  }
}
struct CvArgs { const float* src; int ldn, k0, n0; bf16_t* dst; int ldk, mode, nrows; };
__device__ __forceinline__ CvArgs cve_args(const Ctx& c, int l, int it) {
  const KP p = c.p; unsigned char* ws = p->ws; CvArgs a;
  if (it < 2 * CVE_EXP) { const int up = it / CVE_EXP, r = it % CVE_EXP, e = r >> 4, t = r & 15;
    a = {p->in[up ? I_WU : I_WG] + ((long)(l * 64 + e)) * 1024 * 256, 256, (t >> 1) * 128, (t & 1) * 128, (bf16_t*)(ws + WT_WGU) + (long)e * 512 * 1024, 1024, 1 + up, 512}; return a; }
  it -= 2 * CVE_EXP;
  if (it < CVE_EXP) { const int e = it >> 4, t = it & 15;
    a = {p->in[I_WD] + ((long)(l * 64 + e)) * 256 * 1024, 1024, (t >> 3) * 128, (t & 7) * 128, (bf16_t*)(ws + WT_WD) + (long)e * 1024 * 256, 256, 0, 1024}; return a; }
  it -= CVE_EXP;
  if (it < 2 * CVE_SH) { const int up = it / CVE_SH, t = it % CVE_SH;
    a = {p->in[up ? I_SHU : I_SHG] + (long)l * 1024 * 256, 256, (t >> 1) * 128, (t & 1) * 128, (bf16_t*)(ws + WT_WGU) + (long)64 * 512 * 1024, 1024, 1 + up, 512}; return a; }
  it -= 2 * CVE_SH;
  { a = {p->in[I_SHD] + (long)l * 256 * 1024, 1024, (it >> 3) * 128, (it & 7) * 128, (bf16_t*)(ws + WT_WD) + (long)64 * 1024 * 256, 256, 0, 1024}; }
  return a;
}
template <int DOWN>
__device__ __forceinline__ void conv_stream_E(const Ctx& c, int l, int r0, int step, int n) {
  if (r0 >= n) return;
  f32x4 va[16], vb[16];
  CvArgs a0 = cve_args(c, l, DOWN == 2 ? r0 : DOWN ? cve_dn_item(r0) : cve_gu_item(r0)), a1 = a0;
  tconvB_load(c, a0.src, a0.ldn, a0.k0, a0.n0, va);
#define CVE_IT_(R) (DOWN == 2 ? (R) : DOWN ? cve_dn_item(R) : cve_gu_item(R))
#define CVE_FIN_(V, A) tconvB_finish(c, V, (A).k0, (A).n0, (A).dst, (A).ldk, (A).mode, (A).nrows)
#pragma unroll 1
  for (int r = r0; r < n; r += 2 * step) {
    const bool h1 = r + step < n;
    a1 = cve_args(c, l, CVE_IT_(h1 ? r + step : r)); tconvB_load(c, a1.src, a1.ldn, a1.k0, a1.n0, vb);
    CVE_FIN_(va, a0);
    if (!h1) { asm volatile("s_waitcnt vmcnt(0)" ::: "memory"); break; }
    const bool h2 = r + 2 * step < n;
    a0 = cve_args(c, l, CVE_IT_(h2 ? r + 2 * step : r + step)); tconvB_load(c, a0.src, a0.ldn, a0.k0, a0.n0, va);
    CVE_FIN_(vb, a1);
  }
  asm volatile("s_waitcnt vmcnt(0)" ::: "memory");
#undef CVE_IT_
#undef CVE_FIN_
}
__device__ __forceinline__ int ded_index(const Ctx& c, int nded) { const int ns = c.fnblk >> 3, slot = c.fblk >> 3; return slot >= ns - nded ? ((slot - (ns - nded)) * 8 + (c.fblk & 7)) * 2 + c.hb : -1; }


__device__ __forceinline__ void mod_item(const Ctx& c, int it) {
  const KP p = c.p;
  const int l = it / 96, cg_ = it % 96, tid = c.ftid;
  LAS float* sact = (LAS float*)c.flds;
  LAS float* red = sact + 9 * 1024;
  __syncthreads();
  for (int i = tid; i < 9 * 1024; i += 512) {
    const int r = i >> 10, k = i & 1023;
    const float v = (r < 8) ? p->in[I_C][r * 1024 + k] : p->in[I_CCTX][k];
    sact[i] = v / (1.0f + __expf(-v));
  }
  __syncthreads();
  const int kg = tid >> 6, n = cg_ * 64 + (tid & 63);
  const float* w = p->in[I_WMOD] + (long)l * 1024 * 6144 + n;
  float a[9];
#pragma unroll
  for (int r = 0; r < 9; ++r) a[r] = 0.f;
#pragma unroll 1
  for (int k0 = kg * 128; k0 < kg * 128 + 128; k0 += 16) {
    float wv[16];
#pragma unroll
    for (int q = 0; q < 16; ++q) wv[q] = w[(long)(k0 + q) * 6144];
#pragma unroll
    for (int q4 = 0; q4 < 4; ++q4)
#pragma unroll
      for (int r = 0; r < 9; ++r) {
        const f32x4 s = *(LAS f32x4*)(sact + r * 1024 + k0 + 4 * q4);
        a[r] += s[0] * wv[4 * q4] + s[1] * wv[4 * q4 + 1] + s[2] * wv[4 * q4 + 2] + s[3] * wv[4 * q4 + 3];
      }
  }
#pragma unroll
  for (int r = 0; r < 9; ++r) red[(kg * 9 + r) * 64 + (tid & 63)] = a[r];
  __syncthreads();
  for (int i = tid; i < 9 * 64; i += 512) {
    const int r = i >> 6, nn = i & 63;
    float s = 0.f;
#pragma unroll
    for (int g = 0; g < 8; ++g) s += red[(g * 9 + r) * 64 + nn];
    ((float*)(p->ws + OFF_MOD))[((long)l * 9 + r) * 6144 + cg_ * 64 + nn] = s + p->in[I_BMOD][l * 6144 + cg_ * 64 + nn];
  }
}

__device__ __forceinline__ void sincos_d(double th, float& s, float& co) {
  const double TWO_PI = 6.283185307179586476925;
  const double k = __builtin_rint(th / TWO_PI);
  const double r = th - k * TWO_PI;
  const double h = r * 0.125, h2 = h * h;
  double sh = h * (1.0 + h2 * (-1.0 / 6.0 + h2 * (1.0 / 120.0 + h2 * (-1.0 / 5040.0 + h2 * (1.0 / 362880.0 + h2 * (-1.0 / 39916800.0))))));
  double ch = 1.0 + h2 * (-0.5 + h2 * (1.0 / 24.0 + h2 * (-1.0 / 720.0 + h2 * (1.0 / 40320.0 + h2 * (-1.0 / 3628800.0 + h2 * (1.0 / 479001600.0))))));
#pragma unroll
  for (int i = 0; i < 3; ++i) { const double s2 = 2.0 * sh * ch, c2 = 1.0 - 2.0 * sh * sh; sh = s2; ch = c2; }
  s = (float)sh; co = (float)ch;
}
__device__ __forceinline__ void phase_rope_tables(const Ctx& c) {
  float* hc = (float*)(c.p->ws + OFF_ROPE); float* hs = hc + 2048 * 32; float* rc = hs + 2048 * 32; float* rs = rc + 2048 * 16;
  const long gt = (long)c.blk * 256 + c.tid, gs = (long)c.nblk * 256;
  for (long i = gt; i < 2048 * 48; i += gs) {
    const int t = (int)(i / 48), j = (int)(i % 48);
    const float row = (float)(t >> 6), col = (float)(t & 63);
    float s, co;
    if (j < 32) { const float ang = ((j < 16) ? row : col) * __builtin_amdgcn_exp2f(-(float)(j & 15) * (13.287712379549449f / 16.0f)); sincos_d((double)ang, s, co); hc[t * 32 + j] = co; hs[t * 32 + j] = s; }
    else { const int jj = j - 32; const float ang = ((jj < 8) ? row : col) * __builtin_amdgcn_exp2f(-(float)(jj & 7) * (13.287712379549449f / 8.0f)); sincos_d((double)ang, s, co); rc[t * 16 + jj] = co; rs[t * 16 + jj] = s; }
  }
}

__device__ __forceinline__ const float* mod_ptr(const Ctx& c, int l, int row) { const int rb = row < NL ? (row >> 11) : 8; return (const float*)(c.p->ws + OFF_MOD) + ((long)l * 9 + rb) * 6144; }
__device__ __forceinline__ float* xs_row(const Ctx& c, int row) { return row < NL ? c.p->out + (long)row * D : (float*)(c.p->ws + OFF_CX) + (long)(row - NL) * D; }
__device__ __forceinline__ bf16_t* xres_row(const Ctx& c, int row) { return (bf16_t*)(c.p->ws + BG_VLO) + (long)row * D; }
__device__ __forceinline__ const float* xin_row(const Ctx& c, int row) { return row < NL ? c.p->in[I_X] + (long)row * D : c.p->in[I_CTX] + (long)(row - NL) * D; }

__device__ __forceinline__ void norm_mod_store(const Ctx& c, const f32x4 (&x)[4], const float* g, const float* sh, const float* sc, bf16_t* orow, bf16_t* orow_lo) {
  float ss = 0.f;
#pragma unroll
  for (int j = 0; j < 4; ++j) ss += x[j][0] * x[j][0] + x[j][1] * x[j][1] + x[j][2] * x[j][2] + x[j][3] * x[j][3];
  const float rs = rsqrtf(wave_sum(ss) * (1.0f / D) + EPS);
#pragma unroll
  for (int j = 0; j < 4; ++j) {
    const int e = 256 * j + 4 * c.lane;
    const f32x4 gv = *(const f32x4*)(g + e), shv = *(const f32x4*)(sh + e), scv = *(const f32x4*)(sc + e);
    float u[4];
#pragma unroll
    for (int i = 0; i < 4; ++i) u[i] = (x[j][i] * rs * gv[i]) * (1.0f + scv[i]) + shv[i];
    u32x2 w; w.x = pk2(u[0], u[1]); w.y = pk2(u[2], u[3]);
    *(u32x2*)(orow + e) = w;
    if (orow_lo) {
      float a, b, cc, d; unpack4(w, a, b, cc, d);
      u32x2 w2; w2.x = pk2(u[0] - a, u[1] - b); w2.y = pk2(u[2] - cc, u[3] - d);
      *(u32x2*)(orow_lo + e) = w2;
    }
  }
}

__device__ __forceinline__ void phase_u0(const Ctx& c) {
  const int gw = c.blk * 4 + c.wid, ngw = c.nblk * 4;
  for (int row = gw; row < NT; row += ngw) {
    const float* xr = xin_row(c, row);
    f32x4 x[4];
#pragma unroll
    for (int j = 0; j < 4; ++j) x[j] = *(const f32x4*)(xr + 256 * j + 4 * c.lane);
    const float* md = mod_ptr(c, 0, row);
    norm_mod_store(c, x, c.p->in[I_GPREMIX], md, md + 1024, (bf16_t*)(c.p->ws + OFF_UH) + (long)row * D, nullptr);
  }
}

struct PlainGemmF {
  const bf16_t* A; const bf16_t* B; bf16_t* C; int lda, ldb, ldc, ntn, nm, tid, lane, wid;
  __device__ __forceinline__ void pre(int) {}
  __device__ __forceinline__ ItemInfo setup(int it, const bf16_t* (&ap)[4], const bf16_t* (&bp)[4]) {
    const int xcd = it & 7, j = it >> 3, per_g = 8 * ntn, g = j / per_g, jj = j - g * per_g;
    const int nml = nm >> 3, gsz = (nml - 8 * g) < 8 ? (nml - 8 * g) : 8;
    const int nt = jj / gsz, mt = (g * 8 + (jj - nt * gsz)) * 8 + xcd; const int co = stage_coff(tid);
#pragma unroll
    for (int i = 0; i < 4; ++i) { ap[i] = A + (long)(mt * 128 + stage_row(tid, i)) * lda + co; bp[i] = B + (long)(nt * 128 + stage_row(tid, i)) * ldb + co; }
    return ItemInfo{mt, nt, 0, 0};
  }
  __device__ __forceinline__ void epi(const ItemInfo& ii, const f32x4 (&acc)[4][4]) {
    const int fr = lane & 15, fq = lane >> 4, wr = wid >> 1, wc = wid & 1;
#pragma unroll
    for (int m = 0; m < 4; ++m) {
      bf16_t* rp = C + (long)(ii.a * 128 + wr * 64 + m * 16 + fr) * ldc + ii.b * 128 + wc * 64 + 4 * fq;
#pragma unroll
      for (int n = 0; n < 4; ++n) { u32x2 w; w.x = pk2(acc[m][n][0], acc[m][n][1]); w.y = pk2(acc[m][n][2], acc[m][n][3]); *(u32x2*)(rp + n * 16) = w; }
    }
  }
};
template <int NW>
struct Plain8F {
  const bf16_t* A; const bf16_t* B; bf16_t* C; int lda, ldb, ldc, ntn, nm, ncols, it0, ftid, lane, fwid;
  __device__ __forceinline__ void pre(int) {}
  __device__ __forceinline__ bool diag() const { return false; }
  __device__ __forceinline__ const bf16_t* Abase() const { return A; }
  __device__ __forceinline__ const bf16_t* Bbase() const { return B; }
  __device__ __forceinline__ ItemInfo setup(int it, unsigned (&ap)[4], unsigned (&bp)[4]) {
    const int tl = it0 + (NW == 8 ? it : (it >> 2)), sub = (NW == 8) ? 0 : (it & 3);
    const int xcd = tl & 7, j = tl >> 3, per_g = 8 * ntn, g = j / per_g, jj = j - g * per_g;
    const int nml = nm >> 3, gsz = (nml - 8 * g) < 8 ? (nml - 8 * g) : 8;
    const int nt = jj / gsz, mt = (g * 8 + (jj - nt * gsz)) * 8 + xcd; const int co = stage_coff(ftid);
    const int col0 = nt * 256 + sub * 64;
#pragma unroll
    for (int i = 0; i < 4; ++i) { ap[i] = (unsigned)((mt * 256 + stage_row8(ftid, i)) * lda + co); bp[i] = (unsigned)((col0 + stage_row8(ftid, i)) * ldb + co); }
    return ItemInfo{mt, col0, 0, 0};
  }
  __device__ __forceinline__ void epi(const ItemInfo& ii, const f32x4 (&acc)[4][NW]) {
    const int fr = lane & 15, fq = lane >> 4, wr = fwid >> 1, wc = fwid & 1;
#pragma unroll
    for (int m = 0; m < 4; ++m) {
      const int colw = ii.b + wc * (NW * 16);
      bf16_t* rp = C + (long)(ii.a * 256 + wr * 64 + m * 16 + fr) * ldc + colw;
#pragma unroll
      for (int n = 0; n < NW; n += 2) {
        u32x2 a, b; a.x = pk2(acc[m][n][0], acc[m][n][1]); a.y = pk2(acc[m][n][2], acc[m][n][3]); b.x = pk2(acc[m][n + 1][0], acc[m][n + 1][1]); b.y = pk2(acc[m][n + 1][2], acc[m][n + 1][3]);
        store_pair_bf16(rp + n * 16, fq, a, b, colw + n * 16 < ncols);
      }
    }
  }
};
struct P8PlainF {
  static constexpr bool HALF_N = true;
  __device__ __forceinline__ bool skip_b1(const p8::Unit& u) const { return u.pn * 256 + 128 >= ncols; }
  static constexpr int BH_ROWS = 128;
  static __device__ __forceinline__ int permB(int R) { return (R & ~31) + p8::perm32(R & 31); }
  static constexpr int K = 1024;
  const bf16_t* A; const bf16_t* B; bf16_t* C; int ldc, ntn, nm, ncols, nfull, blk, nblk;
  __device__ __forceinline__ bool next(int i, p8::Unit& u) const {
    const int tl = blk + i * nblk; if (tl >= nfull) return false;
    const int xcd = tl & 7, j = tl >> 3, per_g = 8 * ntn, g = j / per_g, jj = j - g * per_g;
    const int nml = nm >> 3, gsz = (nml - 8 * g) < 8 ? (nml - 8 * g) : 8;
    const int nt = jj / gsz; u.pn = nt; u.pm = (g * 8 + (jj - nt * gsz)) * 8 + xcd; u.e = 0; u.cnt = 256; u.row0 = u.pm * 256;
    return true;
  }
  __device__ __forceinline__ const char* a_base(const p8::Unit& u) const { return (const char*)(A + (long)u.row0 * K); }
  __device__ __forceinline__ const char* b_base(const p8::Unit& u) const { return (const char*)(B + (long)u.pn * 256 * K); }
  __device__ __forceinline__ void a_offs(const p8::Unit&, const int (&Rr)[2], const int (&Cc)[2], unsigned (&v0)[2], unsigned (&v1)[2]) const {
#pragma unroll
    for (int i = 0; i < 2; ++i) { v0[i] = (unsigned)(Rr[i] * K + Cc[i]) * 2u; v1[i] = (unsigned)((128 + Rr[i]) * K + Cc[i]) * 2u; }
  }
  __device__ __forceinline__ void unit_begin(const p8::Unit&, int, LAS unsigned char*, int, int) const {}
  __device__ __forceinline__ void epi(const f32x4 (&acc)[2][2][4][2], const p8::Unit& u, int wr, int wc, int fr, int fq, int, LAS unsigned char*) const {
#pragma unroll
    for (int ai = 0; ai < 2; ++ai)
#pragma unroll
      for (int m = 0; m < 4; ++m) {
        bf16_t* rp = C + (long)(u.row0 + 128 * ai + 64 * wr + 16 * m + fr) * ldc;
#pragma unroll
        for (int bj = 0; bj < 2; ++bj) {
          const int col = 256 * u.pn + 128 * bj + 32 * wc + 8 * fq;
          const f32x4 a = acc[ai][bj][m][0], b = acc[ai][bj][m][1];
          if (col < ncols) *(u32x4*)(rp + col) = (u32x4){pk2(a[0], a[1]), pk2(a[2], a[3]), pk2(b[0], b[1]), pk2(b[2], b[3])};
        }
      }
  }
};
__device__ __forceinline__ void plain_gemm8(const Ctx& c, const bf16_t* A, const bf16_t* B, bf16_t* C, int lda, int ldb, int ldc, int nm, int ntn, int ncols, int nk) {
  const int ntile = nm * ntn, nfull = (ntile / c.fnblk) * c.fnblk;
  if (nfull > 0) { P8PlainF f{A, B, C, ldc, ntn, nm, ncols, nfull, c.fblk, c.fnblk}; p8::gemm(c, f); }
  if (ntile > nfull) { Plain8F<2> f{A, B, C, lda, ldb, ldc, ntn, nm, ncols, nfull, c.ftid, c.lane, c.fwid}; gemm8_persistent<2>(c, c.fblk, c.fnblk, (ntile - nfull) * 4, nk, f); }
}
__device__ __forceinline__ void phase_inproj(const Ctx& c) {
  plain_gemm8(c, (const bf16_t*)(c.p->ws + OFF_UH), (const bf16_t*)(c.p->ws + WT_WIN), (bf16_t*)(c.p->ws + BG_PROJ), D, D, PLD, NT / 256, 8, PLD, 16);
}

__device__ __forceinline__ void head4(float (&v)[4], bool norm, const float* gain, const f32x4 cs, const f32x4 sn, float scale, int lane) {
  if (norm) {
    float ss = v[0] * v[0] + v[1] * v[1] + v[2] * v[2] + v[3] * v[3];
    ss += swz_xor<1>(ss); ss += swz_xor<2>(ss); ss += swz_xor<4>(ss); ss += swz_xor<8>(ss);
    const float rs = rsqrtf(ss * (1.0f / 64.0f) + EPS);
    const f32x4 g = *(const f32x4*)(gain + 4 * (lane & 15));
#pragma unroll
    for (int i = 0; i < 4; ++i) v[i] = v[i] * rs * g[i];
  }
  const bool first = (lane & 8) == 0;
#pragma unroll
  for (int i = 0; i < 4; ++i) {
    const float pv = swz_xor<8>(v[i]);
    v[i] = (first ? (v[i] * cs[i] - pv * sn[i]) : (pv * sn[i] + v[i] * cs[i])) * scale;
  }
}
struct MixRowIn { u32x2 w0, w1, w4, w5, w6, w7; f32x4 cs, sn, c2, s2; };
__device__ __forceinline__ void mixer_row_load(const Ctx& c, int row, MixRowIn& in) {
  const KP p = c.p; const int lane = c.lane;
  const bf16_t* pr = (const bf16_t*)(p->ws + BG_PROJ) + (long)row * PLD;
  in.w0 = *(const u32x2*)(pr + 4 * lane); in.w1 = *(const u32x2*)(pr + 256 + 4 * lane); in.w4 = *(const u32x2*)(pr + 1024 + 4 * lane);
  in.w5 = *(const u32x2*)(pr + 1280 + 4 * lane); in.w6 = *(const u32x2*)(pr + 1536 + 4 * lane); in.w7 = *(const u32x2*)(pr + 1792 + 4 * (lane & 31));
  in.cs = (f32x4){1.f, 1.f, 1.f, 1.f}; in.sn = (f32x4){0.f, 0.f, 0.f, 0.f}; in.c2 = in.cs; in.s2 = in.sn;
  if (row < NL) {
    const int t = row & 2047;
    const float* hc = (const float*)(p->ws + OFF_ROPE) + t * 32; const float* rc = (const float*)(p->ws + OFF_ROPE) + 2 * 2048 * 32 + t * 16;
    in.cs = *(const f32x4*)(hc + 4 * (lane & 7)); in.sn = *(const f32x4*)(hc + 2048 * 32 + 4 * (lane & 7));
    in.c2 = *(const f32x4*)(rc + 4 * (lane & 3)); in.s2 = *(const f32x4*)(rc + 2048 * 16 + 4 * (lane & 3));
  }
}
__device__ __forceinline__ void mixer_row(const Ctx& c, int l, int row, const MixRowIn& in) {
  const KP p = c.p; const int lane = c.lane;
  bf16_t* pr = (bf16_t*)(p->ws + BG_PROJ) + (long)row * PLD;
  const u32x2 w0 = in.w0, w1 = in.w1, w4 = in.w4, w5 = in.w5, w6 = in.w6, w7 = in.w7;
  const f32x4 cs = in.cs, sn = in.sn, c2 = in.c2, s2 = in.s2;
  const float qscale = 0.125f * LOG2E;
  float v[4];
  unpack4(w0, v[0], v[1], v[2], v[3]); head4(v, true, p->in[I_AQN] + l * 64, cs, sn, qscale, lane);
  { u32x2 o; o.x = pk2(v[0], v[1]); o.y = pk2(v[2], v[3]); *(u32x2*)(pr + 4 * lane) = o; }
  unpack4(w1, v[0], v[1], v[2], v[3]); head4(v, true, p->in[I_AKN] + l * 64, cs, sn, 1.0f, lane);
  if (lane < 32) { u32x2 o; o.x = pk2(v[0], v[1]); o.y = pk2(v[2], v[3]); *(u32x2*)(pr + 256 + 4 * lane) = o; }
  unpack4(w4, v[0], v[1], v[2], v[3]); head4(v, false, nullptr, cs, sn, qscale, lane);
  { u32x2 o; o.x = pk2(v[0], v[1]); o.y = pk2(v[2], v[3]); *(u32x2*)(pr + 1024 + 4 * lane) = o; }
  unpack4(w5, v[0], v[1], v[2], v[3]); head4(v, false, nullptr, cs, sn, 1.0f, lane);
  if (lane < 32) { u32x2 o; o.x = pk2(v[0], v[1]); o.y = pk2(v[2], v[3]); *(u32x2*)(pr + 1280 + 4 * lane) = o; }
  float a6[4], a7[4];
  unpack4(w6, a6[0], a6[1], a6[2], a6[3]); unpack4(w7, a7[0], a7[1], a7[2], a7[3]);
  const float s6 = a6[0] * a6[0] + a6[1] * a6[1] + a6[2] * a6[2] + a6[3] * a6[3], s7 = a7[0] * a7[0] + a7[1] * a7[1] + a7[2] * a7[2] + a7[3] * a7[3];
  const float ssq = wave_sum(lane < 48 ? s6 : 0.f);
  const float sskv = wave_sum((lane >= 48 ? s6 : 0.f) + (lane < 16 ? s7 : 0.f));
  const float rq = rsqrtf(ssq * (1.0f / 192.0f) + EPS), rkv = rsqrtf(sskv * (1.0f / 128.0f) + EPS);
  if (lane < 48) {
    const f32x4 g = *(const f32x4*)(p->in[I_DQN] + l * 192 + 4 * lane);
    u32x2 o; o.x = pk2(a6[0] * rq * g[0], a6[1] * rq * g[1]); o.y = pk2(a6[2] * rq * g[2], a6[3] * rq * g[3]);
    *(u32x2*)((bf16_t*)(p->ws + BG_DQN) + (long)row * 192 + 4 * lane) = o;
  } else {
    const f32x4 g = *(const f32x4*)(p->in[I_DKVN] + l * 128 + 4 * (lane - 48));
    u32x2 o; o.x = pk2(a6[0] * rkv * g[0], a6[1] * rkv * g[1]); o.y = pk2(a6[2] * rkv * g[2], a6[3] * rkv * g[3]);
    *(u32x2*)((bf16_t*)(p->ws + BG_DKVN) + (long)row * 128 + 4 * (lane - 48)) = o;
  }
  if (lane < 16) {
    const f32x4 g = *(const f32x4*)(p->in[I_DKVN] + l * 128 + 64 + 4 * lane);
    u32x2 o; o.x = pk2(a7[0] * rkv * g[0], a7[1] * rkv * g[1]); o.y = pk2(a7[2] * rkv * g[2], a7[3] * rkv * g[3]);
    *(u32x2*)((bf16_t*)(p->ws + BG_DKVN) + (long)row * 128 + 64 + 4 * lane) = o;
  }
  {
    const bool first = (lane & 4) == 0;
    float y[4];
#pragma unroll
    for (int i = 0; i < 4; ++i) { const float pv = swz_xor<4>(a7[i]); y[i] = first ? (a7[i] * c2[i] - pv * s2[i]) : (pv * s2[i] + a7[i] * c2[i]); }
    if (lane >= 16 && lane < 24) {
      u32x2 o; o.x = pk2(y[0], y[1]); o.y = pk2(y[2], y[3]);
      bf16_t* kd = (bf16_t*)(p->ws + BG_KD) + (long)row * 384 + 64 + 4 * (lane - 16);
      *(u32x2*)(kd) = o; *(u32x2*)(kd + 96) = o; *(u32x2*)(kd + 192) = o; *(u32x2*)(kd + 288) = o;
    }
  }
}

__device__ __forceinline__ void lru_scan_item(const Ctx& c, int l, int item) {
  const KP p = c.p;
  const int b = item / 72, rem = item % 72, d = rem / 36, q = rem % 36;
  const int tid = c.tid, lane = c.lane, fr = lane & 15, fq = lane >> 4, h = c.wid;
  const bool isctx = q < 4;
  const int seqlen = isctx ? CL : SEQ;
  const int rowbase = isctx ? NL + b * CL : b * SEQ;
  const int pos0 = (d == 0) ? (isctx ? 64 * q : 64 * q - 256) : (isctx ? 255 - 64 * q : 2303 - 64 * q);
  const int step = (d == 0) ? 1 : -1;
  const bf16_t* PROJ = (const bf16_t*)(p->ws + BG_PROJ);
  LAS bf16_t* XB = (LAS bf16_t*)c.lds;
  __syncthreads();
  {
    const int og = tid & 31, pg = tid >> 5;
    const int pa = pos0 + step * (pg * 8), pb = pos0 + step * (pg * 8 + 7);
    const int pmin = pa < pb ? pa : pb;
    float X[11][8];
    const bf16_t* xbase = PROJ + (long)rowbase * PLD + cBX + og * 8;
#pragma unroll
    for (int k = 0; k < 11; ++k) {
      const int r = pmin - 1 + k;
      u32x4 w = {0u, 0u, 0u, 0u};
      if (r >= 0 && r < seqlen) w = *(const u32x4*)(xbase + (long)r * PLD);
      X[k][0] = __uint_as_float(w.x << 16); X[k][1] = __uint_as_float(w.x & 0xffff0000u); X[k][2] = __uint_as_float(w.y << 16); X[k][3] = __uint_as_float(w.y & 0xffff0000u);
      X[k][4] = __uint_as_float(w.z << 16); X[k][5] = __uint_as_float(w.z & 0xffff0000u); X[k][6] = __uint_as_float(w.w << 16); X[k][7] = __uint_as_float(w.w & 0xffff0000u);
    }
    const float* cw = p->in[I_CONVW] + l * 4 * 256 + og * 8;
    float cwv[4][8], cbv[8];
#pragma unroll
    for (int q = 0; q < 4; ++q) { const f32x4 a = *(const f32x4*)(cw + q * 256), b2 = *(const f32x4*)(cw + q * 256 + 4);
      cwv[q][0] = a[0]; cwv[q][1] = a[1]; cwv[q][2] = a[2]; cwv[q][3] = a[3]; cwv[q][4] = b2[0]; cwv[q][5] = b2[1]; cwv[q][6] = b2[2]; cwv[q][7] = b2[3]; }
    { const f32x4 a = *(const f32x4*)(p->in[I_CONVB] + l * 256 + og * 8), b2 = *(const f32x4*)(p->in[I_CONVB] + l * 256 + og * 8 + 4);
      cbv[0] = a[0]; cbv[1] = a[1]; cbv[2] = a[2]; cbv[3] = a[3]; cbv[4] = b2[0]; cbv[5] = b2[1]; cbv[6] = b2[2]; cbv[7] = b2[3]; }
#pragma unroll
    for (int ii = 0; ii < 8; ++ii) {
      float o[8];
#pragma unroll
      for (int e = 0; e < 8; ++e) {
        const float f0 = cbv[e] + cwv[0][e] * X[ii][e] + cwv[1][e] * X[ii + 1][e] + cwv[2][e] * X[ii + 2][e] + cwv[3][e] * X[ii + 3][e];
        const float f1 = cbv[e] + cwv[0][e] * X[7 - ii][e] + cwv[1][e] * X[8 - ii][e] + cwv[2][e] * X[9 - ii][e] + cwv[3][e] * X[10 - ii][e];
        o[e] = (d == 0) ? f0 : f1;
      }
      u32x4 w; w.x = pk2(o[0], o[1]); w.y = pk2(o[2], o[3]); w.z = pk2(o[4], o[5]); w.w = pk2(o[6], o[7]);
      *(LAS u32x4*)((LAS unsigned char*)XB + (pg * 8 + ii) * 528 + og * 16) = w;
    }
  }
  __syncthreads();
  const bf16_t* wtA = (const bf16_t*)(p->ws + WT_LRU) + ((long)((d * 2 + 0) * 4 + h)) * 4096;
  const bf16_t* wtI = (const bf16_t*)(p->ws + WT_LRU) + ((long)((d * 2 + 1) * 4 + h)) * 4096;
  bf16x8 wa[4][2], wi[4][2];
#pragma unroll
  for (int ni = 0; ni < 4; ++ni)
#pragma unroll
    for (int kk = 0; kk < 2; ++kk) {
      wa[ni][kk] = *(const bf16x8*)(wtA + (ni * 16 + fr) * 64 + kk * 32 + 8 * fq);
      wi[ni][kk] = *(const bf16x8*)(wtI + (ni * 16 + fr) * 64 + kk * 32 + 8 * fq);
    }
  float ba[4], bi[4], sp8[4], H0[4], P0[4];
#pragma unroll
  for (int ni = 0; ni < 4; ++ni) {
    const int ch = 64 * h + 16 * ni + fr;
    ba[ni] = p->in[I_LRUBA][(l * 2 + d) * 256 + ch]; bi[ni] = p->in[I_LRUBI][(l * 2 + d) * 256 + ch];
    const float lam = p->in[I_LRULAM][(l * 2 + d) * 256 + ch];
    const float x = __expf(-lam);
    const float sp = (x < 0.01f) ? x * (1.0f - x * (0.5f - x * (1.0f / 3.0f - 0.25f * x))) : __logf(1.0f + x);
    sp8[ni] = 8.0f * sp; H0[ni] = 0.f; P0[ni] = 1.f;
  }
  bf16_t* HL = (bf16_t*)(p->ws + BG_HL) + ((long)(b * 2 + d) * 2304 + 64 * q) * 256;
  bf16_t* PL = (bf16_t*)(p->ws + BG_PL) + ((long)(b * 2 + d) * 2304 + 64 * q) * 256;
#pragma unroll 1
  for (int mi = 0; mi < 4; ++mi) {
    bf16x8 xf[2];
#pragma unroll
    for (int kk = 0; kk < 2; ++kk) xf[kk] = *(LAS bf16x8*)((LAS unsigned char*)XB + (mi * 16 + fr) * 528 + (64 * h + kk * 32 + 8 * fq) * 2);
#pragma unroll
    for (int ni = 0; ni < 4; ++ni) {
      f32x4 aA = {0.f, 0.f, 0.f, 0.f}, aI = {0.f, 0.f, 0.f, 0.f};
      aA = __builtin_amdgcn_mfma_f32_16x16x32_bf16(xf[0], wa[ni][0], aA, 0, 0, 0);
      aA = __builtin_amdgcn_mfma_f32_16x16x32_bf16(xf[1], wa[ni][1], aA, 0, 0, 0);
      aI = __builtin_amdgcn_mfma_f32_16x16x32_bf16(xf[0], wi[ni][0], aI, 0, 0, 0);
      aI = __builtin_amdgcn_mfma_f32_16x16x32_bf16(xf[1], wi[ni][1], aI, 0, 0, 0);
      const int ch = 64 * h + 16 * ni + fr;
      float Ac[4], hl[4];
#pragma unroll
      for (int j = 0; j < 4; ++j) {
        const float xbv = bf2f(XB[(mi * 16 + 4 * fq + j) * 264 + ch]);
        const float r = sigmoidf_(aA[j] + ba[ni]), ig = sigmoidf_(aI[j] + bi[ni]);
        const float a = __expf(-sp8[ni] * r);
        const float bb = __builtin_amdgcn_sqrtf(fmaxf(1.0f - a * a, 0.f)) * ig * xbv;
        if (j == 0) { Ac[0] = a; hl[0] = bb; } else { Ac[j] = a * Ac[j - 1]; hl[j] = a * hl[j - 1] + bb; }
      }
      float Ai = Ac[3], Bi = hl[3];
      { const float Ap = bperm(Ai, lane - 16), Bp = bperm(Bi, lane - 16); if (fq >= 1) { Bi = Ai * Bp + Bi; Ai = Ai * Ap; } }
      { const float Ap = bperm(Ai, lane - 32), Bp = bperm(Bi, lane - 32); if (fq >= 2) { Bi = Ai * Bp + Bi; Ai = Ai * Ap; } }
      float Ae = bperm(Ai, lane - 16), Be = bperm(Bi, lane - 16);
      if (fq == 0) { Ae = 1.f; Be = 0.f; }
      const float Hin = Ae * H0[ni] + Be, Pin = P0[ni] * Ae;
      float hf3 = 0.f, pf3 = 0.f;
#pragma unroll
      for (int j = 0; j < 4; ++j) {
        const float hf = Ac[j] * Hin + hl[j], pf = Pin * Ac[j];
        const long o = (long)(mi * 16 + 4 * fq + j) * 256 + ch;
        HL[o] = f2bf(hf); PL[o] = f2bf(pf);
        if (j == 3) { hf3 = hf; pf3 = pf; }
      }
      H0[ni] = bperm(hf3, fr + 48); P0[ni] = bperm(pf3, fr + 48);
    }
  }
  if (fq == 0) {
    float* AA = (float*)(p->ws + OFF_AGG) + ((long)(b * 2 + d) * 36 + q) * 256;
    float* AB = AA + 8 * 2 * 36 * 256;
#pragma unroll
    for (int ni = 0; ni < 4; ++ni) { AA[64 * h + 16 * ni + fr] = P0[ni]; AB[64 * h + 16 * ni + fr] = H0[ni]; }
  }
}

__device__ __forceinline__ void phase_mixer_prep(const Ctx& c, int l) {
  for (int it = c.blk; it < CVO_TOTAL; it += c.nblk) conv_item_O(c, l, it);
  for (int it = c.blk; it < 576; it += c.nblk) lru_scan_item(c, l, it);
  const int extra = (576 > c.nblk) ? 576 - c.nblk : 0, nwv = (c.nblk - extra) * 4;
  if (c.blk >= extra) {
    int r = (c.blk - extra) * 4 + c.wid;
    MixRowIn cur, nxt;
    if (r < NT) mixer_row_load(c, r, cur);
#pragma unroll 1
    for (; r < NT; r += nwv) {
      if (r + nwv < NT) mixer_row_load(c, r + nwv, nxt);
      mixer_row(c, l, r, cur);
      cur = nxt;
    }
  }
}

__device__ __forceinline__ void lru_prefix_item(const Ctx& c, int idx) {
  const float* AA = (const float*)(c.p->ws + OFF_AGG) + (long)idx * 36 * 256 + c.tid; const float* AB = AA + 8 * 2 * 36 * 256;
  float* PRE = (float*)(c.p->ws + OFF_AGG + 1572864) + (long)idx * 36 * 256 + c.tid;
  float cy = 0.f;
#pragma unroll 12
  for (int q = 0; q < 36; ++q) { PRE[q * 256] = cy; cy = AA[q * 256] * cy + AB[q * 256]; }
}

__device__ __forceinline__ void phase_mla_up(const Ctx& c, int l) {
  if (c.nblk >= 32 && c.blk >= c.nblk - 16) lru_prefix_item(c, c.blk - (c.nblk - 16));
  else if (c.nblk < 32) for (int i = c.blk; i < 16; i += c.nblk) lru_prefix_item(c, i);
  const KP p = c.p;
  const int lane = c.lane, wid = c.wid, fr = lane & 15, fq = lane >> 4, wr = wid >> 1, wc = wid & 1;
  const int nq = (NT / 128) * 3, nkv = (NT / 128) * 4;
  for (int it = c.blk; it < nq + nkv; it += c.nblk) {
    const bf16_t *ap[4], *bp[4]; f32x4 acc[4][4];
    if (it < nq) {
      const int mt = it / 3, nt = it % 3;
      rows_plain(c, (const bf16_t*)(p->ws + BG_DQN), 192, mt * 128, ap); rows_plain(c, (const bf16_t*)(p->ws + WT_WUQ), 192, nt * 128, bp);
      gemm_core(c, ap, bp, 3, 1, 0, 0, 0, 0, 0, 0, acc);
      const float qs = 0.10206207261596575f * LOG2E;
      const int G0 = 8 * nt + 4 * wc;
      const float* rc = (const float*)(p->ws + OFF_ROPE) + 2 * 2048 * 32; const float* rs = rc + 2048 * 16;
      bf16_t* QD = (bf16_t*)(p->ws + BG_QD);
#pragma unroll
      for (int m = 0; m < 4; ++m) {
        const int row = mt * 128 + wr * 64 + m * 16 + fr;
        const bool lat = row < NL; const int t = row & 2047;
#pragma unroll
        for (int n = 0; n < 4; ++n) {
          f32x4 v = acc[m][n];
          const int g6 = (G0 + n) % 6;
          if (lat && g6 == 4 && n < 3) {
            const f32x4 cs = *(const f32x4*)(rc + t * 16 + 4 * fq), sn = *(const f32x4*)(rs + t * 16 + 4 * fq);
            const f32x4 x1 = acc[m][n], x2 = acc[m][(n < 3) ? n + 1 : n];
            v = x1 * cs - x2 * sn;
          } else if (lat && g6 == 5 && n > 0) {
            const f32x4 cs = *(const f32x4*)(rc + t * 16 + 4 * fq), sn = *(const f32x4*)(rs + t * 16 + 4 * fq);
            const f32x4 x1 = acc[m][(n > 0) ? n - 1 : n], x2 = acc[m][n];
            v = x1 * sn + x2 * cs;
          }
          u32x2 w; w.x = pk2(v[0] * qs, v[1] * qs); w.y = pk2(v[2] * qs, v[3] * qs);
          *(u32x2*)(QD + (long)row * 384 + nt * 128 + wc * 64 + n * 16 + 4 * fq) = w;
        }
      }
    } else {
      const int i2 = it - nq, mt = i2 / 4, nt = i2 % 4;
      rows_plain(c, (const bf16_t*)(p->ws + BG_DKVN), 128, mt * 128, ap); rows_plain(c, (const bf16_t*)(p->ws + WT_WUKV), 128, nt * 128, bp);
      gemm_core(c, ap, bp, 2, 1, 0, 0, 0, 0, 0, 0, acc);
      bf16_t* base = wc == 0 ? (bf16_t*)(p->ws + BG_KD) + nt * 96 : (bf16_t*)(p->ws + BG_VD) + nt * 64;
      const long ld = wc == 0 ? 384 : 256;
#pragma unroll
      for (int m = 0; m < 4; ++m) {
        const int row = mt * 128 + wr * 64 + m * 16 + fr;
#pragma unroll
        for (int n = 0; n < 4; ++n) { u32x2 w; w.x = pk2(acc[m][n][0], acc[m][n][1]); w.y = pk2(acc[m][n][2], acc[m][n][3]); *(u32x2*)(base + (long)row * ld + n * 16 + 4 * fq) = w; }
      }
    }
  }
}

struct AttnSeg { const bf16_t* K; const bf16_t* V; int ntiles; int kabs0; };

template <int DQK>
__device__ __forceinline__ void attn_unit(const Ctx& c, const bf16_t* Q, int ldq, int ldk, int ldv, const AttnSeg s0, const AttnSeg s1, bool mask1, int qabs0,
                                          float m_init, float l_init, bf16_t* O) {
  constexpr int KS = DQK * 2 + 16, NKC = DQK / 8, NCH = 64 * NKC, NKR = (NCH + 511) / 512, NQF = DQK / 16, KBUF = 13312, VBASE = 26624;
  const int tid = c.ftid, lane = c.lane, wid = c.fwid, r32 = lane & 31, hi = lane >> 5;
  const bool g1 = wid >= 4;
  LAS unsigned char* lds = c.flds;
  bf16x8 qf[NQF];
  {
    const bf16_t* qp = Q + (long)(wid * 32 + r32) * ldq + hi * 8;
#pragma unroll
    for (int ks = 0; ks < NQF; ++ks) qf[ks] = *(const bf16x8*)(qp + ks * 16);
  }
  f32x16 o0, o1;
#pragma unroll
  for (int r = 0; r < 16; ++r) { o0[r] = 0.f; o1[r] = 0.f; }
  const bool nosink = l_init == 0.f;
  float m = nosink ? 0.f : m_init, lsum = (hi == 0) ? l_init : 0.f;
  f32x16 negm;
#pragma unroll
  for (int r = 0; r < 16; ++r) negm[r] = -m;
  const int ntot = s0.ntiles + s1.ntiles;
  u32x4 kreg[NKR], vreg[1];
  bf16x8 pf[2][2];
#define ATT_GLOAD(I) do { const int i_ = (I); const bool first_ = i_ < s0.ntiles; const int ii_ = first_ ? i_ : i_ - s0.ntiles; \
    const bf16_t* Kt_ = (first_ ? s0.K : s1.K) + (long)ii_ * 64 * ldk; \
    const bf16_t* Vt_ = (first_ ? s0.V : s1.V) + (long)ii_ * 64 * ldv; \
    _Pragma("unroll") for (int j_ = 0; j_ < NKR; ++j_) { const int id_ = tid + 512 * j_; if (id_ < NCH) kreg[j_] = *(const u32x4*)(Kt_ + (long)(id_ / NKC) * ldk + (id_ % NKC) * 8); } \
    { vreg[0] = *(const u32x4*)(Vt_ + (long)(tid >> 3) * ldv + (tid & 7) * 8); } } while (0)
#define ATT_LWRITE(KBI, VBI) do { LAS unsigned char* b_ = lds + (KBI) * KBUF; \
    _Pragma("unroll") for (int j_ = 0; j_ < NKR; ++j_) { const int id_ = tid + 512 * j_; if (id_ < NCH) *(LAS u32x4*)(b_ + (id_ / NKC) * KS + (id_ % NKC) * 16) = kreg[j_]; } \
    { const int key_ = tid >> 3, d8_ = tid & 7; \
      *(LAS u32x4*)(lds + VBASE + (VBI) * 8192 + ((key_ >> 3) * 2 + (d8_ >> 2)) * 512 + (key_ & 7) * 64 + (d8_ & 3) * 16) = vreg[0]; } } while (0)
#define ATT_PV(VBI) do { LAS unsigned char* vbp_ = lds + VBASE + (VBI) * 8192 + vb; \
    _Pragma("unroll") for (int dt = 0; dt < 2; ++dt) _Pragma("unroll") for (int t = 0; t < 2; ++t) _Pragma("unroll") for (int sp = 0; sp < 2; ++sp) { \
      const int kblk = 4 * t + 2 * sp; \
      const s16x4 lo = __builtin_bit_cast(s16x4, __builtin_amdgcn_ds_read_tr16_b64_v4i16((LAS s16x4*)(vbp_ + ((kblk + 0) * 2 + dt) * 512))); \
      const s16x4 hh = __builtin_bit_cast(s16x4, __builtin_amdgcn_ds_read_tr16_b64_v4i16((LAS s16x4*)(vbp_ + ((kblk + 1) * 2 + dt) * 512))); \
      const bf16x8 vf = (bf16x8){lo[0], lo[1], lo[2], lo[3], hh[0], hh[1], hh[2], hh[3]}; \
      if (dt == 0) o0 = __builtin_amdgcn_mfma_f32_32x32x16_bf16(vf, pf[t][sp], o0, 0, 0, 0); \
      else o1 = __builtin_amdgcn_mfma_f32_32x32x16_bf16(vf, pf[t][sp], o1, 0, 0, 0); \
      if (t == 1 && sp == 1) __builtin_amdgcn_sched_barrier(0); } } while (0)
  __syncthreads();
  ATT_GLOAD(0); ATT_LWRITE(0, 0);
  __syncthreads();
  const int vb = (4 * hi + ((lane & 15) >> 2)) * 64 + ((lane >> 4) & 1) * 32 + (lane & 3) * 8;
  int vcur = 0, vprev = 2;
  for (int i = 0; i < ntot; ++i) {
    if (i + 1 < ntot) ATT_GLOAD(i + 1);
    LAS unsigned char* kb = lds + (i & 1) * KBUF;
    if (g1 && i > 0) ATT_PV(vprev);
    __builtin_amdgcn_sched_barrier(0);
    f32x16 s[2];
    {
      bf16x8 kfa[NQF], kfb[NQF];
#pragma unroll
      for (int ks = 0; ks < NQF; ++ks) kfa[ks] = *(LAS bf16x8*)(kb + r32 * KS + (2 * ks + hi) * 16);
#pragma unroll
      for (int ks = 0; ks < NQF; ++ks) kfb[ks] = *(LAS bf16x8*)(kb + (32 + r32) * KS + (2 * ks + hi) * 16);
      __builtin_amdgcn_sched_barrier(0);
      s[0] = __builtin_amdgcn_mfma_f32_32x32x16_bf16(kfa[0], qf[0], negm, 0, 0, 0);
#pragma unroll
      for (int ks = 1; ks < NQF; ++ks) s[0] = __builtin_amdgcn_mfma_f32_32x32x16_bf16(kfa[ks], qf[ks], s[0], 0, 0, 0);
      s[1] = __builtin_amdgcn_mfma_f32_32x32x16_bf16(kfb[0], qf[0], negm, 0, 0, 0);
#pragma unroll
      for (int ks = 1; ks < NQF; ++ks) s[1] = __builtin_amdgcn_mfma_f32_32x32x16_bf16(kfb[ks], qf[ks], s[1], 0, 0, 0);
      __builtin_amdgcn_sched_barrier(0);
    }
    if (mask1 && i >= s0.ntiles) {
      const int kbase = s1.kabs0 + (i - s0.ntiles) * 64, qa = qabs0 + wid * 32 + r32;
#pragma unroll
      for (int t = 0; t < 2; ++t)
#pragma unroll
        for (int r = 0; r < 16; ++r) { const int dd = kbase + 32 * t + crow(r, hi) - qa; if (dd > 128 || dd < -128) s[t][r] = -1e30f; }
    }
    float mxa = fmaxf(s[0][0], s[0][1]), mxb = fmaxf(s[0][2], s[0][3]), mxc = fmaxf(s[1][0], s[1][1]), mxd = fmaxf(s[1][2], s[1][3]);
#pragma unroll
    for (int r = 4; r < 16; r += 4) {
      mxa = fmaxf(fmaxf(mxa, s[0][r]), s[0][r + 1]); mxb = fmaxf(fmaxf(mxb, s[0][r + 2]), s[0][r + 3]);
      mxc = fmaxf(fmaxf(mxc, s[1][r]), s[1][r + 1]); mxd = fmaxf(fmaxf(mxd, s[1][r + 2]), s[1][r + 3]);
    }
    float mx = fmaxf(fmaxf(mxa, mxb), fmaxf(mxc, mxd));
    mx = xhalf_max(mx);
    const bool force0 = nosink && i == 0;
    if (__any(mx > 8.0f) || force0) {
      const float dm = force0 ? mx : fmaxf(mx, 0.f);
      const float alpha = force0 ? 1.0f : __builtin_amdgcn_exp2f(-dm);
      m += dm;
      lsum *= alpha;
#pragma unroll
      for (int r = 0; r < 16; ++r) { o0[r] *= alpha; o1[r] *= alpha; s[0][r] -= dm; s[1][r] -= dm; negm[r] = -m; }
    }
    f32x2 psa = {0.f, 0.f}, psb = {0.f, 0.f};
#pragma unroll
    for (int t = 0; t < 2; ++t)
#pragma unroll
      for (int r = 0; r < 16; r += 4) {
        s[t][r] = __builtin_amdgcn_exp2f(s[t][r]); s[t][r + 1] = __builtin_amdgcn_exp2f(s[t][r + 1]);
        s[t][r + 2] = __builtin_amdgcn_exp2f(s[t][r + 2]); s[t][r + 3] = __builtin_amdgcn_exp2f(s[t][r + 3]);
        psa += (f32x2){s[t][r], s[t][r + 1]}; psb += (f32x2){s[t][r + 2], s[t][r + 3]};
      }
    psa += psb;
    lsum += psa[0] + psa[1];
    __builtin_amdgcn_sched_barrier(0);
#pragma unroll
    for (int t = 0; t < 2; ++t)
#pragma unroll
      for (int sp = 0; sp < 2; ++sp) {
        u32x4 w; w.x = pk2(s[t][8 * sp + 0], s[t][8 * sp + 1]); w.y = pk2(s[t][8 * sp + 2], s[t][8 * sp + 3]);
        w.z = pk2(s[t][8 * sp + 4], s[t][8 * sp + 5]); w.w = pk2(s[t][8 * sp + 6], s[t][8 * sp + 7]);
        pf[t][sp] = __builtin_bit_cast(bf16x8, w);
      }
    __builtin_amdgcn_sched_barrier(0);
    if (!g1) ATT_PV(vcur);
    const int vnext = (vcur == 2) ? 0 : vcur + 1;
    if (i + 1 < ntot) ATT_LWRITE((i + 1) & 1, vnext);
    vprev = vcur; vcur = vnext;
    __syncthreads();
  }
  if (g1) ATT_PV(vprev);
  const float ltot = xhalf_sum(lsum);
  const float inv = 1.0f / ltot;
  bf16_t* orow = O + (long)(wid * 32 + r32) * D;
#pragma unroll
  for (int g = 0; g < 4; ++g) {
    u32x2 w0, w1;
    w0.x = pk2(o0[4 * g] * inv, o0[4 * g + 1] * inv); w0.y = pk2(o0[4 * g + 2] * inv, o0[4 * g + 3] * inv);
    w1.x = pk2(o1[4 * g] * inv, o1[4 * g + 1] * inv); w1.y = pk2(o1[4 * g + 2] * inv, o1[4 * g + 3] * inv);
    *(u32x2*)(orow + 8 * g + 4 * hi) = w0;
    *(u32x2*)(orow + 32 + 8 * g + 4 * hi) = w1;
  }
#undef ATT_GLOAD
#undef ATT_LWRITE
#undef ATT_PV
}

template <int type>
__device__ __forceinline__ void attn_dispatch(const Ctx& c, int l, int b, int hq, int qb, bool ctxq) {
  const KP p = c.p;
  const bf16_t* PROJ = (const bf16_t*)(p->ws + BG_PROJ);
  bf16_t* YMIX = (bf16_t*)(p->ws + BG_YMIX);
  const int rowq0 = ctxq ? NL + b * CL : b * SEQ + qb * 256;
  const long crow0 = NL + b * CL, lrow0 = (long)b * SEQ;
  if constexpr (type == 0) {
    const bf16_t* QD = (const bf16_t*)(p->ws + BG_QD); const bf16_t* KD = (const bf16_t*)(p->ws + BG_KD); const bf16_t* VD = (const bf16_t*)(p->ws + BG_VD);
    AttnSeg s0{KD + crow0 * 384 + hq * 96, VD + crow0 * 256 + hq * 64, 4, 0};
    AttnSeg s1{KD + lrow0 * 384 + hq * 96, VD + lrow0 * 256 + hq * 64, ctxq ? 0 : 32, 0};
    attn_unit<96>(c, QD + (long)rowq0 * 384 + hq * 96, 384, 384, 256, s0, s1, false, 0, -1e30f, 0.f, YMIX + (long)rowq0 * D + 768 + hq * 64);
  } else if constexpr (type == 1) {
    const int g = hq >> 1;
    AttnSeg s0{PROJ + crow0 * PLD + cAK + g * 64, PROJ + crow0 * PLD + cAV + g * 64, 4, 0};
    AttnSeg s1{PROJ + lrow0 * PLD + cAK + g * 64, PROJ + lrow0 * PLD + cAV + g * 64, ctxq ? 0 : 32, 0};
    attn_unit<64>(c, PROJ + (long)rowq0 * PLD + cAQ + hq * 64, PLD, PLD, PLD, s0, s1, false, 0, -1e30f, 0.f, YMIX + (long)rowq0 * D + hq * 64);
  } else {
    const int g = hq >> 1;
    const float sink = p->in[I_CSINK][l * 4 + hq] * LOG2E;
    AttnSeg s0{PROJ + crow0 * PLD + cCK + g * 64, PROJ + crow0 * PLD + cCV + g * 64, 4, 0};
    int k0 = qb * 256 - 128, k1 = qb * 256 + 384; if (k0 < 0) k0 = 0; if (k1 > SEQ) k1 = SEQ;
    AttnSeg s1{PROJ + (lrow0 + k0) * PLD + cCK + g * 64, PROJ + (lrow0 + k0) * PLD + cCV + g * 64, ctxq ? 0 : (k1 - k0) / 64, k0};
    attn_unit<64>(c, PROJ + (long)rowq0 * PLD + cCQ + hq * 64, PLD, PLD, PLD, s0, s1, true, qb * 256, sink, 1.0f, YMIX + (long)rowq0 * D + 512 + hq * 64);
  }
}

__device__ __forceinline__ void unpack8(const u32x4 w, float (&f)[8]) {
  f[0] = __uint_as_float(w.x << 16); f[1] = __uint_as_float(w.x & 0xffff0000u); f[2] = __uint_as_float(w.y << 16); f[3] = __uint_as_float(w.y & 0xffff0000u);
  f[4] = __uint_as_float(w.z << 16); f[5] = __uint_as_float(w.z & 0xffff0000u); f[6] = __uint_as_float(w.w << 16); f[7] = __uint_as_float(w.w & 0xffff0000u);
}
__device__ __forceinline__ void lru_fix_item(const Ctx& c, int b, bool isctx, int ch64) {
  const KP p = c.p; const int og = c.tid & 31, pg = c.tid >> 5, ch = og * 8;
  const int q0 = isctx ? ch64 : 4 + ch64;
  const int q1 = isctx ? 3 - ch64 : 35 - ch64;
  const float* AA = (const float*)(p->ws + OFF_AGG); const float* AB = AA + 8 * 2 * 36 * 256;
  float c0[8], c1[8];
  {
    const float* PRE = (const float*)(p->ws + OFF_AGG + 1572864);
    const float* p0 = PRE + ((long)(b * 2 + 0) * 36 + q0) * 256 + ch; const float* p1 = PRE + ((long)(b * 2 + 1) * 36 + q1) * 256 + ch;
    const f32x4 a0 = *(const f32x4*)(p0), a1 = *(const f32x4*)(p0 + 4), b0 = *(const f32x4*)(p1), b1 = *(const f32x4*)(p1 + 4);
#pragma unroll
    for (int e = 0; e < 4; ++e) { c0[e] = a0[e]; c0[4 + e] = a1[e]; c1[e] = b0[e]; c1[4 + e] = b1[e]; }
  }
  const bf16_t* HL0 = (const bf16_t*)(p->ws + BG_HL) + ((long)(b * 2 + 0) * 2304 + 64 * q0) * 256 + ch;
  const bf16_t* PL0 = (const bf16_t*)(p->ws + BG_PL) + ((long)(b * 2 + 0) * 2304 + 64 * q0) * 256 + ch;
  const bf16_t* HL1 = (const bf16_t*)(p->ws + BG_HL) + ((long)(b * 2 + 1) * 2304 + 64 * q1) * 256 + ch;
  const bf16_t* PL1 = (const bf16_t*)(p->ws + BG_PL) + ((long)(b * 2 + 1) * 2304 + 64 * q1) * 256 + ch;
  const long row0 = isctx ? NL + b * CL + ch64 * 64 : (long)b * SEQ + ch64 * 64;
  const bf16_t* bg = (const bf16_t*)(p->ws + BG_PROJ) + row0 * PLD + cBG + ch;
  bf16_t* y = (bf16_t*)(p->ws + BG_YMIX) + row0 * D + 256 + ch;
#pragma unroll 4
  for (int ii = 0; ii < 8; ++ii) {
    const int i = pg * 8 + ii;
    float h0[8], p0[8], h1[8], p1[8], g[8];
    unpack8(*(const u32x4*)(HL0 + (long)i * 256), h0); unpack8(*(const u32x4*)(PL0 + (long)i * 256), p0);
    unpack8(*(const u32x4*)(HL1 + (long)(63 - i) * 256), h1); unpack8(*(const u32x4*)(PL1 + (long)(63 - i) * 256), p1);
    unpack8(*(const u32x4*)(bg + (long)i * PLD), g);
    float o[8];
#pragma unroll
    for (int e = 0; e < 8; ++e) o[e] = (h0[e] + p0[e] * c0[e] + h1[e] + p1[e] * c1[e]) * gelu_tanh(g[e]);
    u32x4 w; w.x = pk2(o[0], o[1]); w.y = pk2(o[2], o[3]); w.z = pk2(o[4], o[5]); w.w = pk2(o[6], o[7]);
    *(u32x4*)(y + (long)i * D) = w;
  }
}

__device__ __forceinline__ void phase_mixers(const Ctx& c, int l) {
  for (int u = c.fblk; u < 256; u += c.fnblk) { const int b = u & 7, r = u >> 3; attn_dispatch<0>(c, l, b, r >> 3, r & 7, false); }
  for (int u = c.fblk; u < 256; u += c.fnblk) { const int b = u & 7, r = u >> 3; attn_dispatch<1>(c, l, b, r >> 3, r & 7, false); }
  for (int u = c.fblk; u < 256; u += c.fnblk) { const int b = u & 7, r = u >> 3; attn_dispatch<2>(c, l, b, r >> 3, r & 7, false); }
  for (int i2 = c.blk; i2 < 256; i2 += c.nblk) lru_fix_item(c, i2 >> 5, false, i2 & 31);
  if (l == 0) {
    for (int u = c.fnblk - 1 - c.fblk; u < 32; u += c.fnblk) attn_dispatch<0>(c, l, u & 7, u >> 3, 0, true);
    for (int u = c.fnblk - 33 - c.fblk; u < 32; u += c.fnblk) if (u >= 0) attn_dispatch<1>(c, l, u & 7, u >> 3, 0, true);
    for (int u = c.fnblk - 65 - c.fblk; u < 32; u += c.fnblk) if (u >= 0) attn_dispatch<2>(c, l, u & 7, u >> 3, 0, true);
    for (int i2 = c.nblk - 1 - c.blk; i2 < 32; i2 += c.nblk) lru_fix_item(c, i2 >> 2, true, i2 & 3);
  }
}

__device__ __forceinline__ void phase_outproj(const Ctx& c, int nrows) {
  plain_gemm8(c, (const bf16_t*)(c.p->ws + BG_YMIX), (const bf16_t*)(c.p->ws + WT_WOUT), (bf16_t*)(c.p->ws + BG_YOUT), D, D, D, nrows / 256, 4, D, 16);
}

__device__ __forceinline__ void phase_postmix(const Ctx& c, int l, int nrows) {
  const KP p = c.p;
  const int gw = c.blk * 4 + c.wid, ngw = c.nblk * 4;
  for (int row = gw; row < nrows; row += ngw) {
    const float* xr = xin_row(c, row);
    bf16_t* xo = xres_row(c, row);
    const bf16_t* yr = (const bf16_t*)(p->ws + BG_YOUT) + (long)row * D;
    const float* md = mod_ptr(c, l, row);
    f32x4 y[4], x[4]; float ss = 0.f;
#pragma unroll
    for (int j = 0; j < 4; ++j) {
      const u32x2 w = *(const u32x2*)(yr + 256 * j + 4 * c.lane);
      { float a, b, cc, d; unpack4(w, a, b, cc, d); y[j] = (f32x4){a, b, cc, d}; }
      ss += y[j][0] * y[j][0] + y[j][1] * y[j][1] + y[j][2] * y[j][2] + y[j][3] * y[j][3];
      if (l == 0) x[j] = *(const f32x4*)(xr + 256 * j + 4 * c.lane);
      else { const u32x2 xw = *(const u32x2*)(xo + 256 * j + 4 * c.lane); float a, b, cc, d; unpack4(xw, a, b, cc, d); x[j] = (f32x4){a, b, cc, d}; }
    }
    const float rs = rsqrtf(wave_sum(ss) * (1.0f / D) + EPS);
#pragma unroll
    for (int j = 0; j < 4; ++j) {
      const int e = 256 * j + 4 * c.lane;
      const f32x4 g = *(const f32x4*)(p->in[I_GPOSTMIX] + l * D + e), g1 = *(const f32x4*)(md + 2048 + e);
      x[j] = x[j] + g1 * (y[j] * rs * g);
      { u32x2 xw; xw.x = pk2(x[j][0], x[j][1]); xw.y = pk2(x[j][2], x[j][3]); *(u32x2*)(xo + e) = xw; }
    }
    norm_mod_store(c, x, p->in[I_GPREFFN] + l * D, md + 3072, md + 4096, (bf16_t*)(p->ws + BG_VHI) + (long)row * D, nullptr);
  }
}

__device__ __forceinline__ void phase_router(const Ctx& c, int l, int ntok) {
  const KP p = c.p;
  const int lane = c.lane, wid = c.wid, fr = lane & 15, fq = lane >> 4, wr = wid >> 1, wc = wid & 1, tid = c.tid;
  const int ntile = ntok / 128;
  LAS float* LG = (LAS float*)c.flds;
  LAS float* LG1 = (LAS float*)(c.flds + 65536);
  LAS float* BIAS = LG + 128 * 65;
  LAS int* HIST = (LAS int*)(BIAS + 64);
  const bool h0 = c.hb == 0;
  constexpr int CVE_IDLE = 2600;
  const bool ded = ded_ok(c);
  if (c.fnblk > ntile && c.fblk >= ntile) {
    const int vb = c.blk - 2 * ntile, nvb = c.nblk - 2 * ntile;
    if (ded) conv_stream_E<2>(c, l, vb, nvb, CVE_TOTAL);
    else for (int it = vb; it < CVE_IDLE; it += nvb) conv_item_E(c, l, it);
    return;
  }
  for (int it = c.fblk; it < ntile; it += c.fnblk) {
    const bf16_t *ap[4], *bp[4]; f32x4 acc[4][4];
    rows_plain(c, (const bf16_t*)(p->ws + BG_VHI), D, it * 128, ap); rows_plain(c, (const bf16_t*)(p->ws + WT_RHI), D, 0, bp);
    const long alo = (long)(BG_VLO - BG_VHI) / 2, ho = (long)c.hb * 512;
    gemm_core(c, ap, bp, 8, 1, ho, 0, 0, ho, 0, 0, acc); (void)alo;
    {
      LAS float* PX = (LAS float*)c.lds;
      __syncthreads();
      if (wc == 1) {
#pragma unroll
        for (int m = 0; m < 4; ++m)
#pragma unroll
          for (int n = 0; n < 4; ++n)
#pragma unroll
            for (int j = 0; j < 4; ++j) PX[(wr * 64 + m * 16 + fr) * 65 + n * 16 + 4 * fq + j] = acc[m][n][j];
      }
      __syncthreads();
      if (wc == 0) {
#pragma unroll
        for (int m = 0; m < 4; ++m)
#pragma unroll
          for (int n = 0; n < 4; ++n)
#pragma unroll
            for (int j = 0; j < 4; ++j) acc[m][n][j] += PX[(wr * 64 + m * 16 + fr) * 65 + n * 16 + 4 * fq + j];
      }
      __syncthreads();
    }
    if (!h0 && wc == 0) {
#pragma unroll
      for (int m = 0; m < 4; ++m)
#pragma unroll
        for (int n = 0; n < 4; ++n)
#pragma unroll
          for (int j = 0; j < 4; ++j) LG1[(wr * 64 + m * 16 + fr) * 65 + n * 16 + 4 * fq + j] = acc[m][n][j];
    }
    __syncthreads();
    if (h0 && wc == 0) {
#pragma unroll
      for (int m = 0; m < 4; ++m)
#pragma unroll
        for (int n = 0; n < 4; ++n)
#pragma unroll
          for (int j = 0; j < 4; ++j) { const int ix = (wr * 64 + m * 16 + fr) * 65 + n * 16 + 4 * fq + j; LG[ix] = acc[m][n][j] + LG1[ix]; }
    }
    if (h0 && tid < 64) { BIAS[tid] = p->in[I_RB][l * 64 + tid]; HIST[tid] = 0; }
    __syncthreads();
    if (h0 && tid < 128) {
      LAS float* lg = LG + tid * 65;
      for (int e = 0; e < 64; ++e) lg[e] = 1.0f / (1.0f + __expf(-lg[e]));
      float gs[8];
#pragma unroll
      for (int g = 0; g < 8; ++g) {
        float m1 = -INFINITY, m2 = -INFINITY;
        for (int e = 0; e < 8; ++e) { const float v = lg[g * 8 + e] + BIAS[g * 8 + e]; if (v > m1) { m2 = m1; m1 = v; } else if (v > m2) m2 = v; }
        gs[g] = m1 + m2;
      }
      unsigned gmask = 0;
#pragma unroll
      for (int k = 0; k < 4; ++k) {
        float best = -INFINITY; int bi = 0;
#pragma unroll
        for (int g = 0; g < 8; ++g) { const bool ok = !((gmask >> g) & 1u) && gs[g] > best; if (ok) { best = gs[g]; bi = g; } }
        gmask |= 1u << bi;
      }
      unsigned long long chosen = 0ull; float wsum = 0.f; int idx[8]; float wv[8];
#pragma unroll
      for (int k = 0; k < 8; ++k) {
        float best = -INFINITY; int bi = 0;
        for (int e = 0; e < 64; ++e) {
          const bool ok = ((gmask >> (e >> 3)) & 1u) && !((chosen >> e) & 1ull);
          const float v = lg[e] + BIAS[e];
          if (ok && v > best) { best = v; bi = e; }
        }
        chosen |= 1ull << bi; idx[k] = bi; wv[k] = lg[bi]; wsum += wv[k];
      }
      const float sc = 2.5f / wsum;
      const int tok = it * 128 + tid;
      int* oi = (int*)(p->ws + RT_IDX) + (long)tok * 8; float* ow = (float*)(p->ws + RT_W) + (long)tok * 8;
#pragma unroll
      for (int k = 0; k < 8; ++k) { oi[k] = idx[k]; ow[k] = wv[k] * sc; atomicAdd((int*)&HIST[idx[k]], 1); }
    }
    __syncthreads();
    if (h0 && tid < 64) ((int*)(p->ws + RT_TCNT))[it * 64 + tid] = HIST[tid];
    __syncthreads();
  }
  if (c.fnblk <= ntile) { for (int it = c.blk; it < CVE_TOTAL; it += c.nblk) conv_item_E(c, l, it); }
  else if (!ded) { for (int it = CVE_IDLE + c.blk; it < CVE_TOTAL; it += 2 * ntile) conv_item_E(c, l, it); }
}

__device__ __forceinline__ void phase_positions(const Ctx& c, int ntok) {
  const KP p = c.p; const int tid = c.tid; const int ntile = ntok / 128;
  LAS int* TOT = (LAS int*)c.lds; LAS int* PRE = TOT + 64; LAS int* BASE = PRE + 64; LAS unsigned* SEL = (LAS unsigned*)(BASE + 64);
  const int* tc = (const int*)(p->ws + RT_TCNT);
  for (int it = c.blk; it < ntile; it += c.nblk) {
    __syncthreads();
    {
      LAS int* T4 = (LAS int*)(SEL + 256); LAS int* P4 = T4 + 256;
      const int e = tid & 63, part = tid >> 6;
      int tot = 0, pre = 0;
#pragma unroll 4
      for (int t = part; t < ntile; t += 4) { const int v = tc[t * 64 + e]; tot += v; if (t < it) pre += v; }
      T4[part * 64 + e] = tot; P4[part * 64 + e] = pre;
      SEL[tid] = 0u;
      __syncthreads();
      if (tid < 64) { TOT[tid] = T4[tid] + T4[64 + tid] + T4[128 + tid] + T4[192 + tid]; PRE[tid] = P4[tid] + P4[64 + tid] + P4[128 + tid] + P4[192 + tid]; }
    }
    __syncthreads();
    if (tid < 64) {
      int off = 0;
      for (int e = 0; e < tid; ++e) off += TOT[e];
      BASE[tid] = off + PRE[tid];
      if (it == 0) { ((int*)(p->ws + RT_EOFF))[tid] = off; ((int*)(p->ws + RT_ECNT))[tid] = TOT[tid]; }
    }
    const int tok = it * 128 + tid;
    int idx[8];
    if (tid < 128) {
      const int* ii = (const int*)(p->ws + RT_IDX) + (long)tok * 8;
#pragma unroll
      for (int k = 0; k < 8; ++k) { idx[k] = ii[k]; atomicOr((unsigned*)&SEL[idx[k] * 4 + (tid >> 5)], 1u << (tid & 31)); }
    }
    __syncthreads();
    if (tid < 128) {
      const float* ww = (const float*)(p->ws + RT_W) + (long)tok * 8;
      const int w = tid >> 5; const unsigned below = (1u << (tid & 31)) - 1u;
#pragma unroll
      for (int k = 0; k < 8; ++k) {
        const int e = idx[k];
        int rank = __popc(SEL[e * 4 + w] & below);
        for (int q = 0; q < w; ++q) rank += __popc(SEL[e * 4 + q]);
        const int pos = BASE[e] + rank;
        ((int*)(p->ws + RT_LTOK))[pos] = tok; ((float*)(p->ws + RT_LW))[pos] = ww[k]; ((int*)(p->ws + RT_POSMAP))[(long)tok * 8 + k] = pos;
      }
    }
  }
}

__device__ __forceinline__ int build_tiles(const Ctx& c, int ntok, LAS int* TAB) {
  __syncthreads();
  if (c.ftid < 64) { TAB[c.ftid] = ((const int*)(c.p->ws + RT_ECNT))[c.ftid]; TAB[64 + c.ftid] = ((const int*)(c.p->ws + RT_EOFF))[c.ftid]; }
  __syncthreads();
  if (c.ftid == 0) {
    const int x = c.fblk & 7; int s = 0;
#pragma unroll 1
    for (int k = 0; k < 8; ++k) { TAB[128 + k] = s; s += (TAB[x + 8 * k] + 255) >> 8; }
    TAB[136] = s;
    const int S = ntok / 256;
    int tot = 0;
#pragma unroll 1
    for (int y = 0; y < 8; ++y) { int r = 0; for (int k = 0; k < 8; ++k) r += (TAB[y + 8 * k] + 255) >> 8; TAB[140 + y] = r; tot += r; }
    unsigned act = 0xffu; int nact = 8, L = 0;
#pragma unroll 1
    for (int itn = 0; itn < 8; ++itn) {
      L = (tot + S) / nact;
      bool changed = false;
#pragma unroll 1
      for (int y = 0; y < 8; ++y) if (((act >> y) & 1u) && TAB[140 + y] > L && nact > 1) { act &= ~(1u << y); --nact; tot -= TAB[140 + y]; changed = true; }
      if (!changed) break;
    }
    int given = 0;
#pragma unroll 1
    for (int y = 0; y < 8; ++y) { int sy = ((act >> y) & 1u) ? L - TAB[140 + y] : 0; if (sy < 0) sy = 0; if (given + sy > S) sy = S - given; TAB[150 + y] = sy; given += sy; }
    int left = S - given;
#pragma unroll 1
    for (int y = 0; y < 8 && left > 0; ++y) if ((act >> y) & 1u) { TAB[150 + y] += 1; --left; }
#pragma unroll 1
    for (int y = 0; y < 8 && left > 0; ++y) { TAB[150 + y] += left; left = 0; }
    int sh0 = 0;
#pragma unroll 1
    for (int y = 0; y < x; ++y) sh0 += TAB[150 + y];
    TAB[138] = sh0; TAB[137] = s + TAB[150 + x];
  }
  __syncthreads();
  return TAB[137];
}
__device__ __forceinline__ void find_local(LAS const int* TAB, int x, int ntok, int tile, int& e, int& rt) {
  int k = 0;
#pragma unroll 1
  for (int q = 1; q < 9; ++q) if (TAB[128 + q] <= tile) k = q;
  if (k < 8) { e = x + 8 * k; rt = tile - TAB[128 + k]; } else { e = 64; rt = TAB[138] + (tile - TAB[136]); }
}

struct P8GateUpF {
  static constexpr int NTN = 2;
  static constexpr bool HALF_N = false;
  __device__ __forceinline__ bool skip_b1(const p8::Unit&) const { return false; }
  static constexpr int BH_ROWS = 128;
  static __device__ __forceinline__ int permB(int R) { return (R & ~31) + p8::perm32(R & 31); }
  LAS const int* TAB; const int* ltok; const bf16_t* V; const bf16_t* W; bf16_t* H; int atot, ntok, xg, slot, ns, nitems, K;
  __device__ __forceinline__ bool next(int i, p8::Unit& u) const {
    const int j = slot + i * ns; if (j >= nitems) return false;
    const int tile = j / NTN; int e, rt; find_local(TAB, xg, ntok, tile, e, rt);
    u.pm = rt; u.pn = j - tile * NTN; u.e = e;
    if (e < 64) { int cnt = TAB[e] - rt * 256; u.cnt = cnt > 256 ? 256 : cnt; u.row0 = TAB[64 + e] + rt * 256; } else { u.cnt = 256; u.row0 = atot + rt * 256; }
    return true;
  }
  __device__ __forceinline__ const char* a_base(const p8::Unit&) const { return (const char*)V; }
  __device__ __forceinline__ const char* b_base(const p8::Unit& u) const { return (const char*)(W + ((long)u.e * 512 + u.pn * 256) * 1024); }
  __device__ __forceinline__ void a_offs(const p8::Unit& u, const int (&Rr)[2], const int (&Cc)[2], unsigned (&v0)[2], unsigned (&v1)[2]) const {
#pragma unroll
    for (int i = 0; i < 2; ++i) {
      const int r0 = Rr[i], r1 = 128 + Rr[i];
      const int t0 = (u.e < 64) ? ltok[u.row0 + (r0 < u.cnt ? r0 : 0)] : u.pm * 256 + r0;
      const int t1 = (u.e < 64) ? ltok[u.row0 + (r1 < u.cnt ? r1 : 0)] : u.pm * 256 + r1;
      v0[i] = (unsigned)(t0 * 1024 + Cc[i]) * 2u; v1[i] = (unsigned)(t1 * 1024 + Cc[i]) * 2u;
    }
  }
  __device__ __forceinline__ void unit_begin(const p8::Unit&, int, LAS unsigned char*, int, int) const {}
  __device__ __forceinline__ void epi(const f32x4 (&acc)[2][2][4][2], const p8::Unit& u, int wr, int wc, int fr, int fq, int, LAS unsigned char*) const {
#pragma unroll
    for (int ai = 0; ai < 2; ++ai)
#pragma unroll
      for (int m = 0; m < 4; ++m) {
        const int rl = 128 * ai + 64 * wr + 16 * m + fr;
        float hv[8];
#pragma unroll
        for (int n = 0; n < 2; ++n)
#pragma unroll
          for (int j = 0; j < 4; ++j) { const float g = acc[ai][0][m][n][j], up = acc[ai][1][m][n][j]; hv[4 * n + j] = g * __builtin_amdgcn_rcpf(1.0f + __expf(-g)) * up; }
        if (rl < u.cnt) *(u32x4*)(H + (long)(u.row0 + rl) * 256 + 128 * u.pn + 32 * wc + 8 * fq) = (u32x4){pk2(hv[0], hv[1]), pk2(hv[2], hv[3]), pk2(hv[4], hv[5]), pk2(hv[6], hv[7])};
      }
  }
};
__device__ __forceinline__ void phase_gateup(const Ctx& c, int l, int ntok) {
  const KP p = c.p;
  int ns = c.fnblk >> 3;
  LAS int* TAB = (LAS int*)(c.flds + LDS_TAB);
  const int ntiles = build_tiles(c, ntok, TAB);
  P8GateUpF f{TAB, (const int*)(p->ws + RT_LTOK), (const bf16_t*)(p->ws + BG_VHI), (const bf16_t*)(p->ws + WT_WGU), (bf16_t*)(p->ws + OFF_UH),
              ntok * 8, ntok, c.fblk & 7, c.fblk >> 3, ns, ntiles * 2, 1024};
  p8::gemm(c, f);
}

struct P8DownF {
  static constexpr int NTN = 4;
  static constexpr bool HALF_N = false;
  __device__ __forceinline__ bool skip_b1(const p8::Unit&) const { return false; }
  static constexpr int BH_ROWS = 8;
  static __device__ __forceinline__ int permB(int R) { return 64 * (R >> 5) + 16 * ((R >> 2) & 3) + 4 * ((R >> 4) & 1) + (R & 3); }
  LAS const int* TAB; const float* lw; const bf16_t* Hm; const bf16_t* W; unsigned char* Y; signed char* YS; int atot, ntok, xg, slot, ns, nitems, K;
  __device__ __forceinline__ bool next(int i, p8::Unit& u) const {
    const int j = slot + i * ns; if (j >= nitems) return false;
    const int tile = j / NTN; int e, rt; find_local(TAB, xg, ntok, tile, e, rt);
    u.pm = rt; u.pn = j - tile * NTN; u.e = e;
    if (e < 64) { int cnt = TAB[e] - rt * 256; u.cnt = cnt > 256 ? 256 : cnt; u.row0 = TAB[64 + e] + rt * 256; } else { u.cnt = 256; u.row0 = atot + rt * 256; }
    return true;
  }
  __device__ __forceinline__ const char* a_base(const p8::Unit& u) const { return (const char*)(Hm + (long)u.row0 * 256); }
  __device__ __forceinline__ const char* b_base(const p8::Unit& u) const { return (const char*)(W + ((long)u.e * 1024 + u.pn * 256) * 256); }
  __device__ __forceinline__ void a_offs(const p8::Unit&, const int (&Rr)[2], const int (&Cc)[2], unsigned (&v0)[2], unsigned (&v1)[2]) const {
#pragma unroll
    for (int i = 0; i < 2; ++i) { v0[i] = (unsigned)(Rr[i] * 256 + Cc[i]) * 2u; v1[i] = (unsigned)((128 + Rr[i]) * 256 + Cc[i]) * 2u; }
  }
  static __device__ __forceinline__ unsigned pk8(const f32x4 v, float scl) {
    typedef short s16x2_ __attribute__((ext_vector_type(2)));
    s16x2_ t = {0, 0};
    t = __builtin_amdgcn_cvt_scalef32_pk_fp8_f32(t, v[0], v[1], scl, false);
    t = __builtin_amdgcn_cvt_scalef32_pk_fp8_f32(t, v[2], v[3], scl, true);
    return __builtin_bit_cast(unsigned, t);
  }
  __device__ __forceinline__ void unit_begin(const p8::Unit&, int, LAS unsigned char*, int, int) const {}
  __device__ __forceinline__ void epi(const f32x4 (&acc)[2][2][4][2], const p8::Unit& u, int wr, int wc, int fr, int fq, int, LAS unsigned char*) const {
#pragma unroll
    for (int ai = 0; ai < 2; ++ai)
#pragma unroll
      for (int m = 0; m < 4; ++m) {
        const int rl = 128 * ai + 64 * wr + 16 * m + fr; const bool ok = rl < u.cnt;
        float mx = 0.f;
#pragma unroll
        for (int bj = 0; bj < 2; ++bj)
#pragma unroll
          for (int n = 0; n < 2; ++n) {
            const f32x4 a = acc[ai][bj][m][n];
            mx = fmaxf(fmaxf(mx, fabsf(a[0])), fabsf(a[1])); mx = fmaxf(fmaxf(mx, fabsf(a[2])), fabsf(a[3]));
          }
        mx = fmaxf(mx, swz_xor<16>(mx));
        int ex = __builtin_amdgcn_frexp_expf(mx); ex = ex < -100 ? -100 : (ex > 100 ? 100 : ex);
        const float s2 = __builtin_amdgcn_ldexpf(1.0f, ex - 8);
        const long row = (long)(u.row0 + rl);
        const u32x4 w = {pk8(acc[ai][0][m][0], s2), pk8(acc[ai][0][m][1], s2), pk8(acc[ai][1][m][0], s2), pk8(acc[ai][1][m][1], s2)};
        if (ok) __builtin_nontemporal_store(w, (u32x4*)(Y + row * 1024 + 256 * u.pn + 64 * wc + 16 * fq));
        if (ok && !(fq & 1)) YS[row * 32 + 8 * u.pn + 2 * wc + (fq >> 1)] = (signed char)ex;
      }
  }
};
__device__ __forceinline__ void phase_down(const Ctx& c, int l, int ntok) {
  const KP p = c.p;
  const int ns = c.fnblk >> 3;
  LAS int* TAB = (LAS int*)(c.flds + LDS_TAB);
  const int ntiles = build_tiles(c, ntok, TAB);
  P8DownF f{TAB, (const float*)(p->ws + RT_LW), (const bf16_t*)(p->ws + OFF_UH), (const bf16_t*)(p->ws + WT_WD), p->ws + BG_Y, (signed char*)(p->ws + BG_YS),
            ntok * 8, ntok, c.fblk & 7, c.fblk >> 3, ns, ntiles * 4, 256};
  p8::gemm(c, f);
}

__device__ __forceinline__ void phase_combine(const Ctx& c, int l, int ntok) {
  const KP p = c.p;
  const int gw = c.blk * 4 + c.wid, ngw = c.nblk * 4, lane = c.lane;
  const unsigned char* Y = p->ws + BG_Y; const signed char* YS = (const signed char*)(p->ws + BG_YS); const int* pm = (const int*)(p->ws + RT_POSMAP);
  const long atot = (long)ntok * 8;
  for (int row = gw; row < ntok; row += ngw) {
    int pos[8];
    { const int4 a = *(const int4*)(pm + (long)row * 8), b = *(const int4*)(pm + (long)row * 8 + 4);
      pos[0] = a.x; pos[1] = a.y; pos[2] = a.z; pos[3] = a.w; pos[4] = b.x; pos[5] = b.y; pos[6] = b.z; pos[7] = b.w; }
    const f32x4 rwa = *(const f32x4*)((const float*)(p->ws + RT_W) + (long)row * 8), rwb = *(const f32x4*)((const float*)(p->ws + RT_W) + (long)row * 8 + 4);
    const float rw[9] = {rwa[0], rwa[1], rwa[2], rwa[3], rwb[0], rwb[1], rwb[2], rwb[3], 1.0f};
    u32x4 yv[9]; int sx[9];
#pragma unroll
    for (int k = 0; k < 9; ++k) {
      const long yr = (k < 8) ? (long)pos[k] : atot + row;
      yv[k] = *(const u32x4*)(Y + yr * 1024 + 16 * lane); sx[k] = YS[yr * 32 + (lane >> 1)];
    }
    bf16_t* xo = xres_row(c, row);
    f32x4 xv[4];
    { float t8[8]; unpack8(*(const u32x4*)(xo + 16 * lane), t8); xv[0] = (f32x4){t8[0], t8[1], t8[2], t8[3]}; xv[1] = (f32x4){t8[4], t8[5], t8[6], t8[7]};
      unpack8(*(const u32x4*)(xo + 16 * lane + 8), t8); xv[2] = (f32x4){t8[0], t8[1], t8[2], t8[3]}; xv[3] = (f32x4){t8[4], t8[5], t8[6], t8[7]}; }
    float f[16];
#pragma unroll
    for (int i = 0; i < 16; ++i) f[i] = 0.f;
#pragma unroll
    for (int k = 0; k < 9; ++k) {
      const float s = __builtin_amdgcn_ldexpf(rw[k], sx[k] - 8);
#pragma unroll
      for (int q = 0; q < 4; ++q) {
        const f32x2 d0 = __builtin_amdgcn_cvt_pk_f32_fp8((int)yv[k][q], false), d1 = __builtin_amdgcn_cvt_pk_f32_fp8((int)yv[k][q], true);
        f[4 * q] += d0[0] * s; f[4 * q + 1] += d0[1] * s; f[4 * q + 2] += d1[0] * s; f[4 * q + 3] += d1[1] * s;
      }
    }
    float ss = 0.f;
#pragma unroll
    for (int i = 0; i < 16; ++i) ss += f[i] * f[i];
    const float rs = rsqrtf(wave_sum(ss) * (1.0f / D) + EPS);
    const float* md = mod_ptr(c, l, row);
    float x[16]; float ss2 = 0.f;
#pragma unroll
    for (int q = 0; q < 4; ++q) {
      const int e = 16 * lane + 4 * q;
      const f32x4 g = *(const f32x4*)(p->in[I_GPOSTFFN] + l * D + e), g2 = *(const f32x4*)(md + 5120 + e);
      f32x4 o;
#pragma unroll
      for (int i = 0; i < 4; ++i) { o[i] = xv[q][i] + g2[i] * (f[4 * q + i] * rs * g[i]); x[4 * q + i] = o[i]; ss2 += o[i] * o[i]; }
      if (l == 1) *(f32x4*)(p->out + (long)row * D + e) = o;
    }
    if (l == 0) {
      *(u32x4*)(xo + 16 * lane) = (u32x4){pk2(x[0], x[1]), pk2(x[2], x[3]), pk2(x[4], x[5]), pk2(x[6], x[7])};
      *(u32x4*)(xo + 16 * lane + 8) = (u32x4){pk2(x[8], x[9]), pk2(x[10], x[11]), pk2(x[12], x[13]), pk2(x[14], x[15])};
    }
    if (l == 0) {
      const float rs2 = rsqrtf(wave_sum(ss2) * (1.0f / D) + EPS);
      const float* md1 = mod_ptr(c, 1, row);
      bf16_t* uo = (bf16_t*)(p->ws + OFF_UH) + (long)row * D;
      float u[16];
#pragma unroll
      for (int q = 0; q < 4; ++q) {
        const int e = 16 * lane + 4 * q;
        const f32x4 g = *(const f32x4*)(p->in[I_GPREMIX] + D + e), shv = *(const f32x4*)(md1 + e), scv = *(const f32x4*)(md1 + 1024 + e);
#pragma unroll
        for (int i = 0; i < 4; ++i) u[4 * q + i] = (x[4 * q + i] * rs2 * g[i]) * (1.0f + scv[i]) + shv[i];
      }
      *(u32x4*)(uo + 16 * lane) = (u32x4){pk2(u[0], u[1]), pk2(u[2], u[3]), pk2(u[4], u[5]), pk2(u[6], u[7])};
      *(u32x4*)(uo + 16 * lane + 8) = (u32x4){pk2(u[8], u[9]), pk2(u[10], u[11]), pk2(u[12], u[13]), pk2(u[14], u[15])};
    }
  }
}

#define XB_TMO      128
#define XB_XCNT(j)  (256  + 64 * (j))
#define XB_XSUB(j)  (1280 + 64 * (j))
#define XB_XGEN(j)  (2304 + 64 * (j))
#define XB_TOP      3328
#define XB_TOPGEN   3392
#define XCD_BAR_WORDS 3456
#define XB_SPIN_CAP (1u << 20)
__device__ __forceinline__ unsigned xb_ld(unsigned* p)              { return __hip_atomic_load(p, __ATOMIC_RELAXED, __HIP_MEMORY_SCOPE_AGENT); }
__device__ __forceinline__ unsigned xb_add(unsigned* p, unsigned v) { return __hip_atomic_fetch_add(p, v, __ATOMIC_RELAXED, __HIP_MEMORY_SCOPE_AGENT); }
__device__ __forceinline__ unsigned xb_xcc_id() { return (unsigned)__builtin_amdgcn_s_getreg((3 << 11) | 20) & 0xFu; }
#define XB_SPIN(cond, bar) do { unsigned _sp = 0; while (cond) { __builtin_amdgcn_s_sleep(1); \
    if ((++_sp & 255u) == 0u) { if (xb_ld(&(bar)[XB_TMO])) break; if (_sp > XB_SPIN_CAP) { atomicAdd(&(bar)[XB_TMO], 1u); break; } } } } while (0)
struct XcdBarrier { unsigned* bar; unsigned x; volatile LAS unsigned* st; };
__device__ __forceinline__ XcdBarrier xcd_barrier_post(unsigned* bar, volatile LAS unsigned* st) {
  XcdBarrier b; b.bar = bar; b.x = xb_xcc_id(); b.st = st;
  if (threadIdx.x == 0) (void)xb_add(&bar[XB_XCNT(b.x)], 1u);
  return b;
}
__device__ __forceinline__ void xcd_barrier_complete(unsigned* bar, unsigned x, unsigned& nloc, unsigned& nx) {
  const unsigned G = gridDim.x * gridDim.y * gridDim.z;
  unsigned sum, cnt, mine, sp = 0u;
  for (;;) {
    sum = 0u; cnt = 0u; mine = 0u;
#pragma unroll
    for (unsigned j = 0; j < 16; ++j) { const unsigned c = xb_ld(&bar[XB_XCNT(j)]); sum += c; cnt += (c > 0u) ? 1u : 0u; mine = (j == x) ? c : mine; }
    if (sum == G) break;
    __builtin_amdgcn_s_sleep(1);
    if ((++sp & 255u) == 0u) { if (xb_ld(&bar[XB_TMO])) break; if (sp > XB_SPIN_CAP) { atomicAdd(&bar[XB_TMO], 1u); break; } }
  }
  nloc = mine > 0u ? mine : 1u; nx = cnt > 0u ? cnt : 1u;
}
__device__ __forceinline__ void xcd_barrier(const XcdBarrier& b, bool leader) {
  asm volatile("s_waitcnt vmcnt(0)" ::: "memory");
  __syncthreads();
  if (leader) {
    unsigned* bar = b.bar;
    __builtin_amdgcn_s_waitcnt(0);
    unsigned nloc = b.st[0], nx = b.st[1];
    if (nloc == 0u) { xcd_barrier_complete(bar, b.x, nloc, nx); b.st[0] = nloc; b.st[1] = nx; }
    const unsigned old = xb_add(&bar[XB_XSUB(b.x)], 1u);
    const unsigned gen = old / nloc;
    if (old + 1u == (gen + 1u) * nloc) {
      __builtin_amdgcn_fence(__ATOMIC_RELEASE, "agent");
      asm volatile("s_waitcnt vmcnt(0)" ::: "memory");
      const unsigned og = xb_add(&bar[XB_TOP], 1u);
      const unsigned tg = og / nx;
      if (og + 1u == (tg + 1u) * nx) xb_add(&bar[XB_TOPGEN], 1u);
      else XB_SPIN(xb_ld(&bar[XB_TOPGEN]) == tg, bar);
      __builtin_amdgcn_fence(__ATOMIC_ACQUIRE, "agent");
      xb_add(&bar[XB_XGEN(b.x)], 1u);
      asm volatile("s_waitcnt vmcnt(0)" ::: "memory");
    } else {
      XB_SPIN(xb_ld(&bar[XB_XGEN(b.x)]) == gen, bar);
      __builtin_amdgcn_fence(__ATOMIC_ACQUIRE, "agent");
      asm volatile("s_waitcnt vmcnt(0)" ::: "memory");
    }
  }
  __syncthreads();
}

__global__ void __launch_bounds__(512, 2) mega(Params p) {
  extern __shared__ __attribute__((aligned(16))) unsigned char lds_raw[];
  Ctx c; c.flds = (LAS unsigned char*)lds_raw; c.l = 0; c.wid0 = __builtin_amdgcn_readfirstlane(threadIdx.x >> 6); relaunder(c);
  volatile LAS unsigned* xst = (volatile LAS unsigned*)(c.flds + LDS_XST);
  if (c.ftid < 4) xst[c.ftid] = 0u;
  __syncthreads();
  (void)xcd_barrier_post((unsigned*)get_ka()->ws, xst);
#define XBAR() do { XcdBarrier xb_; xb_.bar = (unsigned*)get_ka()->ws; xb_.x = xb_xcc_id(); xb_.st = (volatile LAS unsigned*)((LAS unsigned char*)lds_raw + LDS_XST); int w_ = c.wid0; asm volatile("" : "+s"(w_)); \
    unsigned z_; asm volatile("v_mov_b32 %0, 0" : "=v"(z_)); const bool ld_ = (w_ == 0) && (__builtin_amdgcn_mbcnt_hi(~0u, __builtin_amdgcn_mbcnt_lo(~0u, z_)) == 0u); xcd_barrier(xb_, ld_); } while (0)

  relaunder(c); for (int it = c.fblk; it < 192; it += c.fnblk) mod_item(c, it);
  relaunder(c);
  if (c.fnblk == 256) { if (c.fblk >= 192) for (int it = c.blk - 384; it < CVS_TOTAL; it += 128) conv_item_S(c, 0, it); }
  else phase_convert_S(c, 0);
  relaunder(c); phase_rope_tables(c);
  XBAR();
  relaunder(c); phase_u0(c);
  XBAR();
  for (int l = 0; l < 2; ++l) {
    const int ntok = (l == 0) ? NT : NL;
    relaunder(c); phase_inproj(c);
    XBAR();
    relaunder(c); phase_mixer_prep(c, l);
    XBAR();
    relaunder(c); phase_mla_up(c, l);
    XBAR();
    relaunder(c); phase_mixers(c, l);
    XBAR();
    relaunder(c); phase_outproj(c, ntok);
    XBAR();
    relaunder(c); phase_postmix(c, l, ntok);
    XBAR();
    relaunder(c); phase_router(c, l, ntok);
    XBAR();
    relaunder(c); phase_positions(c, ntok);
    XBAR();
    relaunder(c); phase_gateup(c, l, ntok);
    XBAR();
    relaunder(c); phase_down(c, l, ntok);
    XBAR();
    relaunder(c); phase_combine(c, l, ntok);
    if (l == 0) { relaunder(c); phase_convert_S(c, 1); XBAR(); }
  }
}

extern "C" void kernel_launch(void* const* d_in, const int* in_sizes, int n_in, void* d_out, int out_size,
                              void* d_ws, size_t ws_size, hipStream_t stream) {
  static int grid = 0;
  if (!grid) {
    int dev = 0, cus = 0, per_cu = 0;
    (void)hipGetDevice(&dev);
    (void)hipDeviceGetAttribute(&cus, hipDeviceAttributeMultiprocessorCount, dev);
    (void)hipFuncSetAttribute((const void*)mega, hipFuncAttributeMaxDynamicSharedMemorySize, LDS_BYTES);
    (void)hipOccupancyMaxActiveBlocksPerMultiprocessor(&per_cu, (const void*)mega, 512, LDS_BYTES);
    if (per_cu > 1) per_cu = 1;
    if (per_cu < 1) per_cu = 1;
    grid = cus * per_cu; grid -= grid % 8;
    if (ws_size < WS_NEED) fprintf(stderr, "kernel_launch: workspace too small: %zu < %zu\n", ws_size, (size_t)WS_NEED);
  }
  Params p{};
  for (int i = 0; i < N_IN; ++i) p.in[i] = (const float*)d_in[i];
  p.out = (float*)d_out; p.ws = (unsigned char*)d_ws;
  (void)hipMemsetAsync(d_ws, 0, 16384, stream);
  void* args[] = {&p};
  hipError_t e = hipLaunchCooperativeKernel((const void*)mega, dim3(grid), dim3(512), args, LDS_BYTES, stream);
  if (e != hipSuccess) fprintf(stderr, "coop launch failed: %s\n", hipGetErrorString(e));
}
```
